# Optimizing an MI355X kernel written in HIP

```python
import jax, jax.numpy as jnp
from jax import lax
import numpy as np

D_MODEL = 2048
BATCH = 2
SEQ = 8192
DEPTH = 2

HEAD_DIM = 128
N_HEADS_A = 16
N_HEADS_B = 16
MOBA_BLOCK = 256
MOBA_TOPK = 3
MOBA_QCHUNK = 32
SB_QBLOCK = 128
D_FF_DENSE = 5632
N_EXPERTS = 8
MOE_TOPK = 2
D_FF_EXPERT = 7168
N_A_LAYERS = DEPTH // 2
N_B_LAYERS = DEPTH - N_A_LAYERS
N_DENSE_LAYERS = (DEPTH + 1) // 2
N_MOE_LAYERS = DEPTH // 2
RMS_EPS = 1e-6
NEG_INF = -1e30

kernel_name = "yoco_moba_stickbreak_moe_block"


def rms_norm(x, g):
    x32 = x.astype(jnp.float32)
    y = x32 * lax.rsqrt(jnp.mean(x32 * x32, axis=-1, keepdims=True) + RMS_EPS)
    return y.astype(x.dtype) * g


def split_heads(t, n_heads):
    b, s, _ = t.shape
    return t.reshape(b, s, n_heads, HEAD_DIM).transpose(0, 2, 1, 3)


def merge_heads(t):
    b, h, s, d = t.shape
    return t.transpose(0, 2, 1, 3).reshape(b, s, h * d)


def alibi_slopes(n_heads):
    return jnp.asarray(2.0 ** (-8.0 * np.arange(1, n_heads + 1) / n_heads), dtype=jnp.float32)


def moba_attention(q, k, v):
    b, h, s, dh = q.shape
    nb = -(-s // MOBA_BLOCK)
    sp = nb * MOBA_BLOCK
    pad = ((0, 0), (0, 0), (0, sp - s), (0, 0))
    q, k, v = jnp.pad(q, pad), jnp.pad(k, pad), jnp.pad(v, pad)
    k_sel = min(MOBA_TOPK, nb)
    scale = dh ** -0.5
    kb = k.reshape(b, h, nb, MOBA_BLOCK, dh)
    vb = v.reshape(b, h, nb, MOBA_BLOCK, dh)
    kmean = jnp.mean(kb.astype(jnp.float32), axis=3)
    qblk = jnp.arange(sp) // MOBA_BLOCK
    gate = jnp.einsum('bhsd,bhnd->bhsn', q.astype(jnp.float32), kmean)
    past = jnp.arange(nb)[None, :] < qblk[:, None]
    gate = jnp.where(past[None, None], gate, NEG_INF)
    _, sel = lax.top_k(gate, k_sel)
    slopes = alibi_slopes(h)
    bi = jnp.arange(b)[:, None, None, None]
    hi = jnp.arange(h)[None, :, None, None]
    offs = jnp.arange(MOBA_BLOCK)
    C = MOBA_QCHUNK

    def chunk(c):
        t0 = c * C
        qc = lax.dynamic_slice_in_dim(q, t0, C, axis=2)
        selc = lax.dynamic_slice_in_dim(sel, t0, C, axis=2)
        tq = t0 + jnp.arange(C)
        valid = jnp.arange(k_sel)[None, :] < (tq // MOBA_BLOCK)[:, None]
        ks = kb[bi, hi, selc]
        vs = vb[bi, hi, selc]
        own = t0 // MOBA_BLOCK
        ko = lax.dynamic_index_in_dim(kb, own, axis=2, keepdims=False)
        vo = lax.dynamic_index_in_dim(vb, own, axis=2, keepdims=False)
        s_sel = jnp.einsum('bhcd,bhckld->bhckl', qc, ks).astype(jnp.float32) * scale
        s_own = jnp.einsum('bhcd,bhld->bhcl', qc, ko).astype(jnp.float32) * scale
        kpos_sel = selc[..., None] * MOBA_BLOCK + offs
        dist_sel = (tq[None, None, :, None, None] - kpos_sel).astype(jnp.float32)
        s_sel = s_sel - slopes[None, :, None, None, None] * dist_sel
        s_sel = jnp.where(valid[None, None, :, :, None], s_sel, NEG_INF)
        dist_own = tq[:, None] - (own * MOBA_BLOCK + offs)[None, :]
        s_own = jnp.where((dist_own >= 0)[None, None],
                          s_own - slopes[None, :, None, None] * dist_own.astype(jnp.float32)[None, None],
                          NEG_INF)
        scores = jnp.concatenate([s_sel.reshape(b, h, C, k_sel * MOBA_BLOCK), s_own], axis=-1)
        p = jax.nn.softmax(scores, axis=-1).astype(v.dtype)
        p_sel = p[..., :k_sel * MOBA_BLOCK].reshape(b, h, C, k_sel, MOBA_BLOCK)
        p_own = p[..., k_sel * MOBA_BLOCK:]
        return (jnp.einsum('bhckl,bhckld->bhcd', p_sel, vs)
                + jnp.einsum('bhcl,bhld->bhcd', p_own, vo))

    outs = lax.map(chunk, jnp.arange(sp // C))
    out = outs.transpose(1, 2, 0, 3, 4).reshape(b, h, sp, dh)
    return out[:, :, :s]


def stick_breaking_attention(q, k, v):
    b, h, s, dh = q.shape
    scale = dh ** -0.5
    kpos = jnp.arange(s)

    def block(i):
        t0 = i * SB_QBLOCK
        qb = lax.dynamic_slice_in_dim(q, t0, SB_QBLOCK, axis=2)
        z = jnp.einsum('bhqd,bhkd->bhqk', qb, k).astype(jnp.float32) * scale
        tq = t0 + jnp.arange(SB_QBLOCK)
        causal = (kpos[None, :] < tq[:, None])[None, None]
        log_keep = jnp.where(causal, jax.nn.log_sigmoid(-z), 0.0)
        suffix = lax.cumsum(log_keep, axis=3, reverse=True) - log_keep
        w = jnp.where(causal, jnp.exp(jax.nn.log_sigmoid(z) + suffix), 0.0)
        return jnp.einsum('bhqk,bhkd->bhqd', w.astype(v.dtype), v)

    outs = lax.map(block, jnp.arange(s // SB_QBLOCK))
    return outs.transpose(1, 2, 0, 3, 4).reshape(b, h, s, dh)


def swiglu(x, w1, w3, w2):
    return (jax.nn.silu(x @ w1) * (x @ w3)) @ w2


def moe_swiglu(x, w_router, w1, w3, w2):
    b, s, d = x.shape
    xf = x.reshape(-1, d)
    logits = (xf @ w_router).astype(jnp.float32)
    top_val, top_idx = lax.top_k(logits, MOE_TOPK)
    top_w = jax.nn.softmax(top_val, axis=-1)
    gates = jnp.sum(jax.nn.one_hot(top_idx, N_EXPERTS, dtype=jnp.float32) * top_w[..., None], axis=1)
    gates = gates.astype(x.dtype)
    out = jnp.zeros_like(xf)
    for e in range(N_EXPERTS):
        out = out + gates[:, e:e + 1] * swiglu(xf, w1[e], w3[e], w2[e])
    return out.reshape(b, s, d)


def setup_inputs(seed: int = 0) -> dict:
    key = jax.random.key(seed)
    ks = jax.random.split(key, 20)
    D = D_MODEL
    wa = N_HEADS_A * HEAD_DIM
    wb = N_HEADS_B * HEAD_DIM

    def w(k, shape, fan_in):
        return jax.random.normal(k, shape, dtype=jnp.float32) * (fan_in ** -0.5)

    def gain(k, shape):
        return 1.0 + 0.02 * jax.random.normal(k, shape, dtype=jnp.float32)

    return {
        "x": jax.random.normal(ks[0], (BATCH, SEQ, D), dtype=jnp.float32),
        "attn_norm_g": gain(ks[1], (DEPTH, D)),
        "ffn_norm_g": gain(ks[2], (DEPTH, D)),
        "a_w_qkv": w(ks[3], (N_A_LAYERS, D, 3 * wa), D),
        "a_w_o": w(ks[4], (N_A_LAYERS, wa, D), wa),
        "kv_norm_g": gain(ks[5], (D,)),
        "b_w_kv": w(ks[6], (D, 2 * wb), D),
        "b_w_q": w(ks[7], (N_B_LAYERS, D, wb), D),
        "b_w_o": w(ks[8], (N_B_LAYERS, wb, D), wb),
        "dense_w1": w(ks[9], (N_DENSE_LAYERS, D, D_FF_DENSE), D),
        "dense_w3": w(ks[10], (N_DENSE_LAYERS, D, D_FF_DENSE), D),
        "dense_w2": w(ks[11], (N_DENSE_LAYERS, D_FF_DENSE, D), D_FF_DENSE),
        "moe_w_router": w(ks[12], (N_MOE_LAYERS, D, N_EXPERTS), D),
        "moe_w1": w(ks[13], (N_MOE_LAYERS, N_EXPERTS, D, D_FF_EXPERT), D),
        "moe_w3": w(ks[14], (N_MOE_LAYERS, N_EXPERTS, D, D_FF_EXPERT), D),
        "moe_w2": w(ks[15], (N_MOE_LAYERS, N_EXPERTS, D_FF_EXPERT, D), D_FF_EXPERT),
        "final_norm_g": gain(ks[16], (D,)),
    }


def reference(x, attn_norm_g, ffn_norm_g, a_w_qkv, a_w_o, kv_norm_g, b_w_kv, b_w_q, b_w_o,
              dense_w1, dense_w3, dense_w2, moe_w_router, moe_w1, moe_w3, moe_w2, final_norm_g):
    h = x
    k_sh = None
    v_sh = None
    for layer in range(DEPTH):
        if layer == N_A_LAYERS:
            kv = rms_norm(h, kv_norm_g) @ b_w_kv
            k_flat, v_flat = jnp.split(kv, 2, axis=-1)
            k_sh = split_heads(k_flat, N_HEADS_B)
            v_sh = split_heads(v_flat, N_HEADS_B)
        xn = rms_norm(h, attn_norm_g[layer])
        if layer < N_A_LAYERS:
            qkv = xn @ a_w_qkv[layer]
            q, k, v = jnp.split(qkv, 3, axis=-1)
            mix = moba_attention(split_heads(q, N_HEADS_A), split_heads(k, N_HEADS_A),
                                 split_heads(v, N_HEADS_A))
            h = h + merge_heads(mix) @ a_w_o[layer]
        else:
            j = layer - N_A_LAYERS
            q = split_heads(xn @ b_w_q[j], N_HEADS_B)
            mix = stick_breaking_attention(q, k_sh, v_sh)
            h = h + merge_heads(mix) @ b_w_o[j]
        xn = rms_norm(h, ffn_norm_g[layer])
        if layer % 2 == 0:
            i = layer // 2
            h = h + swiglu(xn, dense_w1[i], dense_w3[i], dense_w2[i])
        else:
            i = layer // 2
            h = h + moe_swiglu(xn, moe_w_router[i], moe_w1[i], moe_w3[i], moe_w2[i])
    return rms_norm(h, final_norm_g)
```

```cpp
#include <hip/hip_runtime.h>
#include <cstdio>
#include <cstdint>
namespace pg8 {
#define PG8_LAS __attribute__((address_space(3)))
typedef unsigned short bf16_t;
typedef short bf16x8 __attribute__((ext_vector_type(8)));
typedef float f32x4 __attribute__((ext_vector_type(4)));
typedef unsigned u32x4 __attribute__((ext_vector_type(4)));
constexpr int BM = 256, BK = 64, HALF = 128, HTB = HALF * BK * 2  , STAGE_BYTES = 8 * HTB, NXCD = 8, WGM = 8;

__host__ __device__ __forceinline__ int lds_byte(int r, int c) { const int st = (r >> 4) * 2 + (c >> 5), rr = r & 15, cc = c & 31, ob = rr * 64 + cc * 2; return st * 1024 + (ob ^ (((ob >> 9) & 1) << 5)); }
__host__ __device__ __forceinline__ void stage_rc(int b, int& R, int& C) { const int st = b / 1024, sb = b % 1024, swz = sb ^ (((sb >> 9) & 1) << 5); R = (st >> 1) * 16 + swz / 64; C = (st & 1) * 32 + (swz % 64) / 2; }
__host__ __device__ __forceinline__ int perm32(int rho) { const int n = rho >> 4, i = rho & 15; return 8 * (i >> 2) + 4 * n + (i & 3); }

struct Unit { int pm, pn; size_t boff; };
struct Gemm { const bf16_t* A; const bf16_t* Bt; int M, N, K; };

struct StaticOrder {
    int nM, nN, nwg, G, c;
    __host__ __device__ void init(int M, int N, int G_, int c_) { nM = M / BM; nN = N / BM; nwg = nM * nN; G = G_; c = c_; }
    __host__ __device__ bool next(int i, Unit& u) const {
        const long L = (long)i * G + c; if (L >= nwg) return false;
        int wgid = (int)L; { const int q = nwg / NXCD, r = nwg % NXCD, xcd = wgid % NXCD, off = wgid / NXCD; wgid = (xcd < r ? xcd * (q + 1) : r * (q + 1) + (xcd - r) * q) + off; }
        const int nig = WGM * nN, gid = wgid / nig, fm = gid * WGM, gsz = (nM - fm) < WGM ? (nM - fm) : WGM;
        u.pm = fm + ((wgid % nig) % gsz); u.pn = (wgid % nig) / gsz; u.boff = 0; return true;
    }
    __device__ __forceinline__ void a_ready(const Unit&) const {}
    __device__ __forceinline__ void done(const Unit&) const {}
};
struct MoeOrder {
    StaticOrder so; int t1, t2, t3, t4, t5, t6, t7; size_t estride;
    __device__ bool next(int i, Unit& u) const {
        if (!so.next(i, u)) return false;
        const int e = (u.pm >= t1) + (u.pm >= t2) + (u.pm >= t3) + (u.pm >= t4) + (u.pm >= t5) + (u.pm >= t6) + (u.pm >= t7);
        u.boff = (size_t)e * estride; return true;
    }
    __device__ __forceinline__ void a_ready(const Unit&) const {}
    __device__ __forceinline__ void done(const Unit&) const {}
};

__device__ __forceinline__ unsigned cvt_pk_bf16(float lo, float hi) { unsigned r; asm volatile("v_cvt_pk_bf16_f32 %0, %1, %2" : "=v"(r) : "v"(lo), "v"(hi)); return r; }
struct EpiBf16 {
    static constexpr bool PERM = true, AFTER_DRAIN = false;
    bf16_t* O; int ldc;
    __device__ __forceinline__ void operator()(const f32x4 (&acc)[2][2][4][2], const Unit& u, int wr, int wc, int fr, int fq) const {
        const int row0 = u.pm * BM + wr * 64 + fr, col0 = u.pn * BM + wc * 32 + 8 * fq;
#pragma unroll
        for (int ai = 0; ai < 2; ++ai)
#pragma unroll
            for (int m = 0; m < 4; ++m) { bf16_t* rowp = O + (size_t)(row0 + ai * HALF + m * 16) * ldc + col0;
#pragma unroll
                for (int bj = 0; bj < 2; ++bj) { const f32x4 v0 = acc[ai][bj][m][0], v1 = acc[ai][bj][m][1];
                    u32x4 w; w.x = cvt_pk_bf16(v0[0], v0[1]); w.y = cvt_pk_bf16(v0[2], v0[3]); w.z = cvt_pk_bf16(v1[0], v1[1]); w.w = cvt_pk_bf16(v1[2], v1[3]);
                    *(u32x4*)(rowp + bj * HALF) = w; } }
    }
};
struct EpiResF32 {
    static constexpr bool PERM = false, AFTER_DRAIN = false;
    const float* base; float* C; int ldc;
    __device__ __forceinline__ void operator()(const f32x4 (&acc)[2][2][4][2], const Unit& u, int wr, int wc, int fr, int fq) const {
        const int row0 = u.pm * BM + wr * 64 + fr, col0 = u.pn * BM + wc * 32 + 4 * fq;
#pragma unroll
        for (int ai = 0; ai < 2; ++ai)
#pragma unroll
            for (int m = 0; m < 4; ++m) { const size_t off = (size_t)(row0 + ai * HALF + m * 16) * ldc + col0;
                f32x4 r[2][2];
#pragma unroll
                for (int bj = 0; bj < 2; ++bj)
#pragma unroll
                    for (int n = 0; n < 2; ++n) r[bj][n] = base ? *(const f32x4*)(base + off + bj * HALF + n * 16) : (f32x4){0.f, 0.f, 0.f, 0.f};
#pragma unroll
                for (int bj = 0; bj < 2; ++bj)
#pragma unroll
                    for (int n = 0; n < 2; ++n) *(f32x4*)(C + off + bj * HALF + n * 16) = acc[ai][bj][m][n] + r[bj][n];
                asm volatile("" ::: "memory"); }
    }
};
__device__ __forceinline__ float silu_mul(float g, float u) { const float e = __builtin_amdgcn_exp2f(g * -1.4426950408889634f); return g * __builtin_amdgcn_rcpf(1.0f + e) * u; }
struct EpiSwiGLU {
    static constexpr bool PERM = true, AFTER_DRAIN = false;
    bf16_t* O; int ldc;
    __device__ __forceinline__ void operator()(const f32x4 (&acc)[2][2][4][2], const Unit& u, int wr, int wc, int fr, int fq) const {
        const int row0 = u.pm * BM + wr * 64 + fr, col0 = u.pn * HALF + wc * 32 + 8 * fq;
#pragma unroll
        for (int ai = 0; ai < 2; ++ai)
#pragma unroll
            for (int m = 0; m < 4; ++m) { bf16_t* rowp = O + (size_t)(row0 + ai * HALF + m * 16) * ldc + col0;
                const f32x4 g0 = acc[ai][0][m][0], g1 = acc[ai][0][m][1], u0 = acc[ai][1][m][0], u1 = acc[ai][1][m][1];
                u32x4 w; w.x = cvt_pk_bf16(silu_mul(g0[0], u0[0]), silu_mul(g0[1], u0[1])); w.y = cvt_pk_bf16(silu_mul(g0[2], u0[2]), silu_mul(g0[3], u0[3]));
                w.z = cvt_pk_bf16(silu_mul(g1[0], u1[0]), silu_mul(g1[1], u1[1])); w.w = cvt_pk_bf16(silu_mul(g1[2], u1[2]), silu_mul(g1[3], u1[3]));
                *(u32x4*)rowp = w; }
    }
};

template <class Epi, class Sched, bool ALIGN_EPI = false, bool SP2 = false>
__device__ __forceinline__ void gemm_phase(PG8_LAS unsigned char* lds, const Gemm g, const Sched& S, const Epi& E) {
    const int tid = threadIdx.x, wid = __builtin_amdgcn_readfirstlane(tid >> 6), lane = tid & 63, wr = wid >> 2, wc = wid & 3, fr = lane & 15, fq = lane >> 4;
    const int K = g.K, nt = K / BK;
    unsigned voffA[2], voffB[2];
#pragma unroll
    for (int i = 0; i < 2; ++i) { int R, C; stage_rc(tid * 16 + i * 8192, R, C); const int Rb = Epi::PERM ? ((R & ~31) + perm32(R & 31)) : R;
        voffA[i] = (unsigned)(R * K + C) * 2u; voffB[i] = (unsigned)(Rb * K + C) * 2u; }
    const size_t kstep = (size_t)(BK * 2);
    const size_t hstep = (size_t)HALF * K * 2;
    const size_t tstep = 2 * hstep;
    const unsigned ldsw = (unsigned)wid * 1024u;
    const int aoff = lds_byte(wr * 64 + fr, fq * 8), boff = lds_byte(wc * 32 + fr, fq * 8);
#define PG8_SA(b, h) (((b) * 2 + (h)) * HTB)
#define PG8_SB(b, h) ((4 + (b) * 2 + (h)) * HTB)
#define PG8_STAGE(bufoff, gbase, voff) do { _Pragma("unroll") for (int _i = 0; _i < 2; ++_i) \
        __builtin_amdgcn_global_load_lds((const unsigned*)((const char*)(gbase) + (voff)[_i]), (PG8_LAS unsigned*)(lds + (bufoff) + ldsw + _i * 8192), 16, 0, 0); } while (0)
#define PG8_LDA(dst, b, h) do { _Pragma("unroll") for (int m = 0; m < 4; ++m) _Pragma("unroll") for (int k = 0; k < 2; ++k) dst[m][k] = *(const PG8_LAS bf16x8*)(lds + PG8_SA(b, h) + aoff + m * 2048 + k * 1024); } while (0)
#define PG8_LDB(dst, b, h) do { _Pragma("unroll") for (int n = 0; n < 2; ++n) _Pragma("unroll") for (int k = 0; k < 2; ++k) dst[n][k] = *(const PG8_LAS bf16x8*)(lds + PG8_SB(b, h) + boff + n * 2048 + k * 1024); } while (0)
#define PG8_MMA(ai, bj, At, Bt) do { __builtin_amdgcn_s_setprio(1); _Pragma("unroll") for (int m = 0; m < 4; ++m) _Pragma("unroll") for (int n = 0; n < 2; ++n) _Pragma("unroll") for (int k = 0; k < 2; ++k) \
        acc[ai][bj][m][n] = __builtin_amdgcn_mfma_f32_16x16x32_bf16(Bt[n][k], At[m][k], acc[ai][bj][m][n], 0, 0, 0); __builtin_amdgcn_s_setprio(0); } while (0)
#define PG8_WAIT_V(n) asm volatile("s_waitcnt vmcnt(" #n ")" ::: "memory")
#define PG8_WAIT_L(n) asm volatile("s_waitcnt lgkmcnt(" #n ")" ::: "memory")
#define PG8_BAR __builtin_amdgcn_s_barrier()
#define PG8_SCHED __builtin_amdgcn_sched_barrier(0)
    Unit cur, nxt; int ui = 0;
    if (!S.next(0, cur)) return;
    f32x4 acc[2][2][4][2];
#pragma unroll
    for (int a = 0; a < 2; ++a)
#pragma unroll
        for (int b = 0; b < 2; ++b)
#pragma unroll
            for (int m = 0; m < 4; ++m)
#pragma unroll
                for (int n = 0; n < 2; ++n) acc[a][b][m][n] = (f32x4){0.f, 0.f, 0.f, 0.f};
    bf16x8 At[4][2], B0[2][2], B1[2][2];
    const char* cA = (const char*)g.A + (size_t)cur.pm * tstep; const char* cB = (const char*)g.Bt + cur.boff + (size_t)cur.pn * tstep;
    S.a_ready(cur);
    if constexpr (SP2) {
        PG8_STAGE(PG8_SB(0, 0), cB, voffB); PG8_STAGE(PG8_SB(0, 1), cB + hstep, voffB); PG8_STAGE(PG8_SA(0, 0), cA, voffA); PG8_STAGE(PG8_SA(0, 1), cA + hstep, voffA);
        if (wr == 1) PG8_BAR;
        PG8_WAIT_V(2); PG8_BAR;
        PG8_STAGE(PG8_SB(1, 0), cB + kstep, voffB); PG8_STAGE(PG8_SA(1, 0), cA + kstep, voffA); PG8_STAGE(PG8_SB(1, 1), cB + hstep + kstep, voffB);
        PG8_WAIT_V(6); PG8_BAR;
    } else {
        PG8_STAGE(PG8_SB(0, 0), cB, voffB); PG8_STAGE(PG8_SA(0, 0), cA, voffA); PG8_STAGE(PG8_SB(0, 1), cB + hstep, voffB); PG8_STAGE(PG8_SA(0, 1), cA + hstep, voffA);
        if (wr == 1) PG8_BAR;
        PG8_WAIT_V(4); PG8_BAR;
        PG8_STAGE(PG8_SB(1, 0), cB + kstep, voffB); PG8_STAGE(PG8_SA(1, 0), cA + kstep, voffA); PG8_STAGE(PG8_SB(1, 1), cB + hstep + kstep, voffB);
        PG8_WAIT_V(6); PG8_BAR;
    }
    for (;;) {
        const bool has_next = S.next(ui + 1, nxt);
        const char* nA = has_next ? (const char*)g.A + (size_t)nxt.pm * tstep : cA; const char* nB = has_next ? (const char*)g.Bt + nxt.boff + (size_t)nxt.pn * tstep : cB;
        for (int t = 0; t < nt; t += 2) {
            const bool last = (t == nt - 2);
            const char* a1 = cA + (size_t)(t + 1) * kstep;
            const char* a2 = last ? nA : cA + (size_t)(t + 2) * kstep; const char* b2 = last ? nB : cB + (size_t)(t + 2) * kstep;
            const char* a3 = a2 + kstep; const char* b3 = b2 + kstep;
            if (last && has_next) S.a_ready(nxt);
            if constexpr (SP2) {
            PG8_LDB(B0, 0, 0); PG8_LDB(B1, 0, 1); PG8_SCHED; PG8_LDA(At, 0, 0); PG8_STAGE(PG8_SA(1, 1), a1 + hstep, voffA);
            PG8_WAIT_V(8); PG8_WAIT_L(0); PG8_BAR; PG8_MMA(0, 0, At, B0); PG8_MMA(0, 1, At, B1); PG8_BAR; PG8_SCHED;
            PG8_LDA(At, 0, 1); PG8_STAGE(PG8_SB(0, 0), b2, voffB); PG8_STAGE(PG8_SB(0, 1), b2 + hstep, voffB); PG8_STAGE(PG8_SA(0, 0), a2, voffA);
            PG8_WAIT_V(8); PG8_WAIT_L(0); PG8_BAR; PG8_MMA(1, 0, At, B0); PG8_MMA(1, 1, At, B1); PG8_BAR; PG8_SCHED;
            PG8_LDB(B0, 1, 0); PG8_LDB(B1, 1, 1); PG8_SCHED; PG8_LDA(At, 1, 0); PG8_STAGE(PG8_SA(0, 1), a2 + hstep, voffA);
            PG8_WAIT_V(8); PG8_WAIT_L(0); PG8_BAR; PG8_MMA(0, 0, At, B0); PG8_MMA(0, 1, At, B1); PG8_BAR; PG8_SCHED;
            PG8_LDA(At, 1, 1); PG8_STAGE(PG8_SB(1, 0), b3, voffB); PG8_STAGE(PG8_SB(1, 1), b3 + hstep, voffB); PG8_STAGE(PG8_SA(1, 0), a3, voffA);
            PG8_WAIT_V(8); PG8_WAIT_L(0); PG8_BAR; PG8_MMA(1, 0, At, B0); PG8_MMA(1, 1, At, B1); PG8_BAR; PG8_SCHED;
            } else {
            PG8_LDB(B0, 0, 0); PG8_SCHED; PG8_LDA(At, 0, 0); PG8_STAGE(PG8_SA(1, 1), a1 + hstep, voffA);
            PG8_WAIT_L(8); PG8_BAR; PG8_WAIT_L(0); PG8_MMA(0, 0, At, B0); PG8_BAR; PG8_SCHED;
            PG8_LDB(B1, 0, 1); PG8_STAGE(PG8_SB(0, 0), b2, voffB);
            PG8_BAR; PG8_WAIT_L(0); PG8_MMA(0, 1, At, B1); PG8_BAR;
            PG8_LDA(At, 0, 1); PG8_STAGE(PG8_SA(0, 0), a2, voffA);
            PG8_BAR; PG8_WAIT_L(0); PG8_MMA(1, 0, At, B0); PG8_BAR; PG8_SCHED;
            PG8_STAGE(PG8_SB(0, 1), b2 + hstep, voffB);
            PG8_WAIT_V(6); PG8_BAR; PG8_MMA(1, 1, At, B1); PG8_BAR;
            PG8_LDB(B0, 1, 0); PG8_SCHED; PG8_LDA(At, 1, 0); PG8_STAGE(PG8_SA(0, 1), a2 + hstep, voffA);
            PG8_WAIT_L(8); PG8_BAR; PG8_WAIT_L(0); PG8_MMA(0, 0, At, B0); PG8_BAR; PG8_SCHED;
            PG8_LDB(B1, 1, 1); PG8_STAGE(PG8_SB(1, 0), b3, voffB);
            PG8_BAR; PG8_WAIT_L(0); PG8_MMA(0, 1, At, B1); PG8_BAR;
            PG8_LDA(At, 1, 1); PG8_STAGE(PG8_SA(1, 0), a3, voffA);
            PG8_BAR; PG8_WAIT_L(0); PG8_MMA(1, 0, At, B0); PG8_BAR; PG8_SCHED;
            PG8_STAGE(PG8_SB(1, 1), b3 + hstep, voffB);
            PG8_WAIT_V(6); PG8_BAR; PG8_MMA(1, 1, At, B1); PG8_BAR;
            }
        }
        if constexpr (ALIGN_EPI) { if (wr == 0) PG8_BAR; }
        if constexpr (!Epi::AFTER_DRAIN) { E(acc, cur, wr, wc, fr, fq); S.done(cur); }
        if (!has_next) break;
#pragma unroll
        for (int a = 0; a < 2; ++a)
#pragma unroll
            for (int b = 0; b < 2; ++b)
#pragma unroll
                for (int m = 0; m < 4; ++m)
#pragma unroll
                    for (int n = 0; n < 2; ++n) acc[a][b][m][n] = (f32x4){0.f, 0.f, 0.f, 0.f};
        cur = nxt; cA = nA; cB = nB; ++ui;
        if constexpr (ALIGN_EPI) { if (wr == 1) PG8_BAR; }
    }
    PG8_WAIT_V(0);
    if constexpr (!ALIGN_EPI) { if (wr == 0) PG8_BAR; }
    PG8_BAR;
    if constexpr (Epi::AFTER_DRAIN) { E.fused(acc, cur, wr, wc, fr, fq, lds, wid, lane); S.done(cur); }
#undef PG8_SA
#undef PG8_SB
#undef PG8_STAGE
#undef PG8_LDA
#undef PG8_LDB
#undef PG8_MMA
#undef PG8_WAIT_V
#undef PG8_WAIT_L
#undef PG8_BAR
#undef PG8_SCHED
}
}

constexpr int BATCH = 2, SEQ = 8192, DM = 2048, MTOK = BATCH * SEQ, NH = 16, HD = 128, FFD = 5632, NE = 8, FFE = 7168, NBLK = SEQ / 256;
constexpr float RMS_EPS = 1e-6f;
constexpr int NWAVES = 8;
constexpr int NPHASE = 17;
#ifndef MK_N_LAUNCHES
#define MK_N_LAUNCHES 17
#endif
constexpr int N_LAUNCHES = MK_N_LAUNCHES;
static_assert(N_LAUNCHES == 1 || N_LAUNCHES == NPHASE, "MK_N_LAUNCHES is 1 or NPHASE");

constexpr size_t MiB = 1u << 20, KiB = 1u << 10;
constexpr size_t WS_CTL = 0, CTL_ZERO_BYTES = 1 * MiB;
constexpr size_t WS_KMEAN = 1 * MiB;
constexpr size_t WS_WRG = 1 * MiB + 512 * KiB;
constexpr size_t WS_TOKE = 1 * MiB + 640 * KiB;
constexpr size_t WS_TOKG = 1 * MiB + 768 * KiB;
constexpr size_t WS_TOKR = 1 * MiB + 896 * KiB;
constexpr size_t WS_TOKP = 2 * MiB;
constexpr size_t WS_CNT = 2 * MiB + 128 * KiB;
constexpr size_t WS_META = 2 * MiB + 192 * KiB;
constexpr size_t WS_WQK0 = 4 * MiB, WS_WV0 = 20 * MiB, WS_WO0 = 28 * MiB, WS_W13D = 36 * MiB, WS_W2D = 80 * MiB;
constexpr size_t WS_WQK1 = 102 * MiB, WS_WV1 = 118 * MiB, WS_WO1 = 126 * MiB, WS_W13M = 134 * MiB, WS_W2M = 582 * MiB;
constexpr size_t WS_H = 806 * MiB;
constexpr size_t WS_Y = 934 * MiB;
constexpr size_t WS_QK = 998 * MiB, WS_VT = 1126 * MiB, WS_AO = 1190 * MiB;
constexpr size_t WS_XS = 998 * MiB, WS_YS = 998 * MiB;
constexpr size_t WS_HID = 1270 * MiB;
constexpr size_t WS_END = 1746 * MiB;
constexpr int MOE_ROWS = 34816;
constexpr int CW_TMO = 0, CW_CODE = 1, CW_BAR = 4096;

constexpr int LDS_BYTES = 147456;
constexpr int MISC_OFF = LDS_BYTES - 256;
constexpr int RING_BYTES = 131072;

#define GAS __attribute__((address_space(1)))
#define LAS __attribute__((address_space(3)))
typedef unsigned short bf16;
typedef unsigned v4u __attribute__((ext_vector_type(4)));
typedef float f32x4 __attribute__((ext_vector_type(4)));
typedef short bf16x8 __attribute__((ext_vector_type(8)));
typedef GAS unsigned gu32;
typedef GAS unsigned long long gu64;
#define RLX_AGENT __ATOMIC_RELAXED, __HIP_MEMORY_SCOPE_AGENT
#define LDS_WAIT() asm volatile("s_waitcnt lgkmcnt(0)" ::: "memory")
#define VM_WAIT() asm volatile("s_waitcnt vmcnt(0)" ::: "memory")
__device__ __forceinline__ unsigned long long rt() { return __builtin_amdgcn_s_memrealtime(); }
__device__ __forceinline__ unsigned f2bf(float f) { unsigned u = __builtin_bit_cast(unsigned, f); return (u + 0x7fffu + ((u >> 16) & 1u)) >> 16; }
__device__ __forceinline__ unsigned pk2(float lo, float hi) { return f2bf(lo) | (f2bf(hi) << 16); }

#define XB_TMO      128
#define XB_XCNT(j)  (256  + 64 * (j))
#define XB_XSUB(j)  (1280 + 64 * (j))
#define XB_XGEN(j)  (2304 + 64 * (j))
#define XB_TOP      3328
#define XB_TOPGEN   3392
#define XCD_BAR_WORDS 3456
#define XB_SPIN_CAP (1u << 18)

__device__ __forceinline__ unsigned xb_ld(unsigned* p)              { return __hip_atomic_load(p, __ATOMIC_RELAXED, __HIP_MEMORY_SCOPE_AGENT); }
__device__ __forceinline__ unsigned xb_add(unsigned* p, unsigned v) { return __hip_atomic_fetch_add(p, v, __ATOMIC_RELAXED, __HIP_MEMORY_SCOPE_AGENT); }
__device__ __forceinline__ unsigned xb_xcc_id() { return (unsigned)__builtin_amdgcn_s_getreg((3 << 11) | 20) & 0xFu; }
#define XB_SPIN(cond, bar) do { unsigned _sp = 0; while (cond) { __builtin_amdgcn_s_sleep(1); \
    if ((++_sp & 255u) == 0u) { if (xb_ld(&(bar)[XB_TMO])) break; if (_sp > XB_SPIN_CAP) { atomicAdd(&(bar)[XB_TMO], 1u); break; } } } } while (0)

struct XcdBarrier {
    unsigned* bar; unsigned x;
    volatile LAS unsigned* st;
};

__device__ __forceinline__ XcdBarrier xcd_barrier_post(unsigned* bar, volatile LAS unsigned* st) {
    XcdBarrier b; b.bar = bar; b.x = xb_xcc_id(); b.st = st;
    if (threadIdx.x == 0) (void)xb_add(&bar[XB_XCNT(b.x)], 1u);
    return b;
}
__device__ __forceinline__ void xcd_barrier_complete(unsigned* bar, unsigned x, unsigned& nloc, unsigned& nx) {
    const unsigned G = gridDim.x * gridDim.y * gridDim.z;
    unsigned sum, cnt, mine, sp = 0u;
    for (;;) {
        sum = 0u; cnt = 0u; mine = 0u;
#pragma unroll
        for (unsigned j = 0; j < 16; ++j) { const unsigned c = xb_ld(&bar[XB_XCNT(j)]); sum += c; cnt += (c > 0u) ? 1u : 0u; mine = (j == x) ? c : mine; }
        if (sum == G) break;
        __builtin_amdgcn_s_sleep(1);
        if ((++sp & 255u) == 0u) { if (xb_ld(&bar[XB_TMO])) break; if (sp > XB_SPIN_CAP) { atomicAdd(&bar[XB_TMO], 1u); break; } }
    }
    nloc = mine > 0u ? mine : 1u; nx = cnt > 0u ? cnt : 1u;
}

__device__ __forceinline__ void xcd_barrier(const XcdBarrier& b) {
    asm volatile("s_waitcnt vmcnt(0)" ::: "memory");
    __syncthreads();
    if (threadIdx.x == 0) {
        unsigned* bar = b.bar;
        __builtin_amdgcn_s_waitcnt(0);
        unsigned nloc = b.st[0], nx = b.st[1];
        if (nloc == 0u) { xcd_barrier_complete(bar, b.x, nloc, nx); b.st[0] = nloc; b.st[1] = nx; }
        const unsigned old = xb_add(&bar[XB_XSUB(b.x)], 1u);
        const unsigned gen = old / nloc;
        if (old + 1u == (gen + 1u) * nloc) {
            __builtin_amdgcn_fence(__ATOMIC_RELEASE, "agent");
            asm volatile("s_waitcnt vmcnt(0)" ::: "memory");
            const unsigned og = xb_add(&bar[XB_TOP], 1u);
            const unsigned tg = og / nx;
            if (og + 1u == (tg + 1u) * nx) xb_add(&bar[XB_TOPGEN], 1u);
            else XB_SPIN(xb_ld(&bar[XB_TOPGEN]) == tg, bar);
            __builtin_amdgcn_fence(__ATOMIC_ACQUIRE, "agent");
            xb_add(&bar[XB_XGEN(b.x)], 1u);
            asm volatile("s_waitcnt vmcnt(0)" ::: "memory");
        } else {
            XB_SPIN(xb_ld(&bar[XB_XGEN(b.x)]) == gen, bar);
            __builtin_amdgcn_fence(__ATOMIC_ACQUIRE, "agent");
            asm volatile("s_waitcnt vmcnt(0)" ::: "memory");
        }
    }
    __syncthreads();
}

typedef float f32x16 __attribute__((ext_vector_type(16)));
typedef float f32x2v __attribute__((ext_vector_type(2)));
typedef __bf16 bf16x2v __attribute__((ext_vector_type(2)));
typedef short s16x4 __attribute__((ext_vector_type(4)));
struct Frame {
    LAS unsigned char* lds;
    volatile LAS unsigned* MISC;
    gu32* ctl;
    int tid, lane, wave;
    int vcu, G;
    const float* in[17]; float* out; unsigned char* ws;
};
__device__ __forceinline__ float wave_sum(float v) {
#pragma unroll
    for (int o = 1; o < 64; o <<= 1) v += __shfl_xor(v, o);
    return v;
}
__device__ __forceinline__ unsigned cvtpk(float lo, float hi) { f32x2v v = {lo, hi}; bf16x2v b = __builtin_convertvector(v, bf16x2v); return __builtin_bit_cast(unsigned, b); }
__device__ __forceinline__ float bf2f(unsigned short b) { return __builtin_bit_cast(float, (unsigned)b << 16); }
__device__ __forceinline__ float swap_lo(float x, float& hi_out) { const unsigned xu = __float_as_uint(x); auto rr = __builtin_amdgcn_permlane32_swap(xu, xu, false, false); const unsigned r0 = rr[0], r1 = rr[1]; hi_out = __uint_as_float(r1); return __uint_as_float(r0); }

__device__ __forceinline__ void tr_item(const float* W, int ld, int k0, int n0, bf16* WT, int drow0, int dK, const float* g, LAS float* scr, int lane) {
    f32x4 v[16]; float gg[16];
#pragma unroll
    for (int q = 0; q < 16; ++q) { const int k = 4 * q + (lane >> 4); v[q] = *(const GAS f32x4*)(W + (size_t)(k0 + k) * ld + n0 + (lane & 15) * 4); gg[q] = g ? g[k0 + k] : 1.0f; }
#pragma unroll
    for (int q = 0; q < 16; ++q) { const int k = 4 * q + (lane >> 4); const f32x4 x = v[q] * gg[q];
        LAS float* s = scr + k * 65 + (lane & 15) * 4; s[0] = x.x; s[1] = x.y; s[2] = x.z; s[3] = x.w; }
    LDS_WAIT(); asm volatile("" ::: "memory");
    const int c = lane & 7, nn = lane >> 3;
#pragma unroll
    for (int jj = 0; jj < 8; ++jj) { const int n = nn + 8 * jj; const LAS float* s = scr + (8 * c) * 65 + n;
        v4u o; o.x = pk2(s[0], s[65]); o.y = pk2(s[130], s[195]); o.z = pk2(s[260], s[325]); o.w = pk2(s[390], s[455]);
        *(GAS v4u*)(WT + (size_t)(drow0 + n) * dK + k0 + 8 * c) = o; }
    LDS_WAIT(); asm volatile("" ::: "memory");
}
__device__ __forceinline__ void tr_job(const float* W, int ld, int K, int N, bf16* WT, const float* g, int mode, int sel, int roff, int item, LAS float* scr, int lane) {
    const int nb = N / 64, kb = item / nb, nn = item % nb, k0 = kb * 64, n0 = nn * 64;
    const int drow0 = mode ? (n0 / 128) * 256 + sel * 128 + (n0 % 128) : roff + n0;
    tr_item(W, ld, k0, n0, WT, drow0, K, g, scr, lane);
}
__device__ __forceinline__ void norm_rows(Frame& F, const float* src, bf16* dst) {
    const int gw = F.vcu * NWAVES + F.wave, NGW = F.G * NWAVES;
    for (int m = gw; m < MTOK; m += NGW) {
        const GAS f32x4* xr = (const GAS f32x4*)(src + (size_t)m * DM) + F.lane;
        f32x4 v[8]; float s = 0.f;
#pragma unroll
        for (int j = 0; j < 8; ++j) { v[j] = xr[64 * j]; s += (v[j].x * v[j].x + v[j].y * v[j].y) + (v[j].z * v[j].z + v[j].w * v[j].w); }
        const float r = 1.0f / sqrtf(wave_sum(s) * (1.0f / DM) + RMS_EPS);
        GAS unsigned long long* o8 = (GAS unsigned long long*)(dst + (size_t)m * DM) + F.lane;
#pragma unroll
        for (int j = 0; j < 8; ++j) o8[64 * j] = (unsigned long long)cvtpk(v[j].x * r, v[j].y * r) | ((unsigned long long)cvtpk(v[j].z * r, v[j].w * r) << 32);
    }
}
__device__ __forceinline__ void p0_prologue(Frame& F) {
    LAS float* scr = (LAS float*)(F.lds + F.wave * 16640);
    const int gw = F.vcu * NWAVES + F.wave, NGW = F.G * NWAVES;
    unsigned char* ws = F.ws;
    const float* attn_g = F.in[1]; const float* ffn_g = F.in[2]; const float* kv_g = F.in[5];
    constexpr int I_QK0 = 32 * 64, I_V0 = 32 * 32, I_O = 32 * 32, I_D13 = 32 * 88, I_D2 = 88 * 32, I_M13 = 32 * 112, I_M2 = 112 * 32;
    constexpr int NITEMS = I_QK0 + I_V0 + I_O + 2 * I_D13 + I_D2 + 4 * I_O + 8 * (2 * I_M13 + I_M2);
    for (int it = gw; it < NITEMS; it += NGW) {
        int r = it; bool hit = false; const float* W = nullptr; int ld = 0, K = 0, N = 0; bf16* WT = nullptr; const float* g = nullptr; int mode = 0, sel = 0, roff = 0;
#define JOB(cnt, W_, ld_, K_, N_, WT_, g_, mode_, sel_, roff_) if (!hit) { if (r < (cnt)) { W = (W_); ld = (ld_); K = (K_); N = (N_); WT = (WT_); g = (g_); mode = (mode_); sel = (sel_); roff = (roff_); hit = true; } else r -= (cnt); }
        JOB(I_QK0, F.in[3], 6144, DM, 4096, (bf16*)(ws + WS_WQK0), attn_g, 0, 0, 0)
        JOB(I_V0, F.in[3] + 4096, 6144, DM, 2048, (bf16*)(ws + WS_WV0), attn_g, 0, 0, 0)
        JOB(I_O, F.in[4], 2048, DM, 2048, (bf16*)(ws + WS_WO0), nullptr, 0, 0, 0)
        JOB(I_D13, F.in[9], FFD, DM, FFD, (bf16*)(ws + WS_W13D), ffn_g, 1, 0, 0)
        JOB(I_D13, F.in[10], FFD, DM, FFD, (bf16*)(ws + WS_W13D), ffn_g, 1, 1, 0)
        JOB(I_D2, F.in[11], DM, FFD, DM, (bf16*)(ws + WS_W2D), nullptr, 0, 0, 0)
        JOB(I_O, F.in[7], 2048, DM, 2048, (bf16*)(ws + WS_WQK1), attn_g + DM, 0, 0, 0)
        JOB(I_O, F.in[6], 4096, DM, 2048, (bf16*)(ws + WS_WQK1), kv_g, 0, 0, 2048)
        JOB(I_O, F.in[6] + 2048, 4096, DM, 2048, (bf16*)(ws + WS_WV1), kv_g, 0, 0, 0)
        JOB(I_O, F.in[8], 2048, DM, 2048, (bf16*)(ws + WS_WO1), nullptr, 0, 0, 0)
        if (!hit) { if (r < 8 * I_M13) { const int e = r / I_M13; r -= e * I_M13; W = F.in[13] + (size_t)e * DM * FFE; ld = FFE; K = DM; N = FFE; WT = (bf16*)(ws + WS_W13M) + (size_t)e * 2 * FFE * DM; g = ffn_g + DM; mode = 1; sel = 0; hit = true; } else r -= 8 * I_M13; }
        if (!hit) { if (r < 8 * I_M13) { const int e = r / I_M13; r -= e * I_M13; W = F.in[14] + (size_t)e * DM * FFE; ld = FFE; K = DM; N = FFE; WT = (bf16*)(ws + WS_W13M) + (size_t)e * 2 * FFE * DM; g = ffn_g + DM; mode = 1; sel = 1; hit = true; } else r -= 8 * I_M13; }
        if (!hit) { const int e = r / I_M2; r -= e * I_M2; W = F.in[15] + (size_t)e * FFE * DM; ld = DM; K = FFE; N = DM; WT = (bf16*)(ws + WS_W2M) + (size_t)e * DM * FFE; hit = true; }
#undef JOB
        tr_job(W, ld, K, N, WT, g, mode, sel, roff, r, scr, F.lane);
    }
    { const int gt = F.vcu * NWAVES * 64 + F.tid; if (gt < DM * NE) { const int k = gt / NE, e = gt % NE; ((float*)(ws + WS_WRG))[e * DM + k] = ffn_g[DM + k] * F.in[12][gt]; } }
    norm_rows(F, F.in[0], (bf16*)(ws + WS_Y));
}

__device__ __forceinline__ void kmean_phase(Frame& F) {
    const bf16* QK = (const bf16*)(F.ws + WS_QK); float* KM = (float*)(F.ws + WS_KMEAN);
    LAS float* part = (LAS float*)F.lds;
    for (int i = 0; i < 4; ++i) {
        const int item = F.vcu + F.G * i; if (item >= BATCH * NH * NBLK) break;
        const int b = item / (NH * NBLK), h = (item / NBLK) % NH, n = item % NBLK;
        const bf16* kp = QK + ((size_t)(b * SEQ + n * 256 + F.wave * 32)) * 4096 + 2048 + h * HD + 2 * F.lane;
        float s0 = 0.f, s1 = 0.f;
#pragma unroll 8
        for (int r = 0; r < 32; ++r) { const unsigned v = *(const GAS unsigned*)(kp + (size_t)r * 4096); s0 += bf2f((unsigned short)(v & 0xffffu)); s1 += bf2f((unsigned short)(v >> 16)); }
        part[F.wave * 128 + 2 * F.lane] = s0; part[F.wave * 128 + 2 * F.lane + 1] = s1;
        __syncthreads();
        if (F.tid < 128) { float s = 0.f;
#pragma unroll
            for (int w = 0; w < 8; ++w) s += part[w * 128 + F.tid];
            KM[(size_t)item * HD + F.tid] = s * (1.0f / 256.0f); }
        __syncthreads();
    }
}

constexpr int ATT_KB = 16384, ATT_VB = 128 * 136, ATT_K0 = 0, ATT_V0 = 2 * ATT_KB, ATT_FLAGS = ATT_V0 + 2 * ATT_VB;
__device__ __forceinline__ int kswz(int row, int colB) { return row * 256 + (colB ^ ((row & 15) << 4)); }
struct TileRegs { v4u k0, k1, v0, v1; };
__device__ __forceinline__ void tile_load(TileRegs& T, const bf16* Kb, const bf16* Vtb, int kb, int tid) {
    const int key0 = tid >> 4, c16 = tid & 15, d0 = tid >> 3, c8 = tid & 7;
    T.k0 = *(const GAS v4u*)(Kb + (size_t)(kb + key0) * 4096 + c16 * 8);
    T.k1 = *(const GAS v4u*)(Kb + (size_t)(kb + key0 + 32) * 4096 + c16 * 8);
    T.v0 = *(const GAS v4u*)(Vtb + (size_t)d0 * MTOK + kb + c8 * 8);
    T.v1 = *(const GAS v4u*)(Vtb + (size_t)(d0 + 64) * MTOK + kb + c8 * 8);
}
__device__ __forceinline__ void tile_store(const TileRegs& T, LAS unsigned char* lds, int buf, int tid) {
    const int key0 = tid >> 4, c16 = tid & 15, d0 = tid >> 3, c8 = tid & 7;
    LAS unsigned char* Kl = lds + ATT_K0 + buf * ATT_KB; LAS unsigned char* Vl = lds + ATT_V0 + buf * ATT_VB;
    *(LAS v4u*)(Kl + kswz(key0, c16 * 16)) = T.k0;
    *(LAS v4u*)(Kl + kswz(key0 + 32, c16 * 16)) = T.k1;
    typedef unsigned v2u __attribute__((ext_vector_type(2)));
    LAS unsigned char* p0 = Vl + d0 * 136 + c8 * 16; LAS unsigned char* p1 = Vl + (d0 + 64) * 136 + c8 * 16;
    *(LAS v2u*)p0 = (v2u){T.v0.x, T.v0.y}; *(LAS v2u*)(p0 + 8) = (v2u){T.v0.z, T.v0.w};
    *(LAS v2u*)p1 = (v2u){T.v1.x, T.v1.y}; *(LAS v2u*)(p1 + 8) = (v2u){T.v1.z, T.v1.w};
}
#define MFMA32(a, b, c) __builtin_amdgcn_mfma_f32_32x32x16_bf16((a), (b), (c), 0, 0, 0)
__device__ __forceinline__ void qk_tile(f32x16& p0, f32x16& p1, const LAS unsigned char* Kl, const bf16x8* qr, int r32, int hi) {
    p0 = (f32x16){}; p1 = (f32x16){};
    const int rowoff = r32 * 256, x = (r32 & 15) << 4;
#pragma unroll
    for (int ks = 0; ks < 8; ++ks) { const int off = rowoff + (((2 * ks + hi) * 16) ^ x);
        const bf16x8 a0 = *(const LAS bf16x8*)(Kl + off), a1 = *(const LAS bf16x8*)(Kl + off + 8192);
        p0 = MFMA32(a0, qr[ks], p0); p1 = MFMA32(a1, qr[ks], p1); }
}
__device__ __forceinline__ bf16x8 pack8(const f32x16& p, int b) {
    v4u w; w.x = cvtpk(p[b], p[b + 1]); w.y = cvtpk(p[b + 2], p[b + 3]); w.z = cvtpk(p[b + 4], p[b + 5]); w.w = cvtpk(p[b + 6], p[b + 7]); return __builtin_bit_cast(bf16x8, w);
}
__device__ __forceinline__ void pv_tile(f32x16* o, const LAS unsigned char* Vl, const f32x16& p0, const f32x16& p1, int r32, int hi) {
    const bf16x8 pb0 = pack8(p0, 0), pb1 = pack8(p0, 8), pb2 = pack8(p1, 0), pb3 = pack8(p1, 8);
    const LAS unsigned char* vp = Vl + r32 * 136 + hi * 8;
#pragma unroll
    for (int db = 0; db < 4; ++db) {
#pragma unroll
        for (int s = 0; s < 4; ++s) {
            const s16x4 lo = *(const LAS s16x4*)(vp + db * (32 * 136) + s * 32), h4 = *(const LAS s16x4*)(vp + db * (32 * 136) + s * 32 + 16);
            const bf16x8 a = (bf16x8){lo[0], lo[1], lo[2], lo[3], h4[0], h4[1], h4[2], h4[3]};
            o[db] = MFMA32(a, s == 0 ? pb0 : s == 1 ? pb1 : s == 2 ? pb2 : pb3, o[db]); } }
}
__device__ __forceinline__ void store_ot(const f32x16* o, float sc, bf16* orow, int hi) {
#pragma unroll
    for (int db = 0; db < 4; ++db)
#pragma unroll
        for (int g = 0; g < 4; ++g) { typedef unsigned v2u __attribute__((ext_vector_type(2)));
            v2u w; w.x = cvtpk(o[db][4 * g] * sc, o[db][4 * g + 1] * sc); w.y = cvtpk(o[db][4 * g + 2] * sc, o[db][4 * g + 3] * sc);
            *(GAS v2u*)(orow + db * 32 + g * 8 + hi * 4) = w; }
}

template <int MODE> __device__ __forceinline__ void moba_unit(Frame& F, int b, int h, int j) {
    const bf16* QK = (const bf16*)(F.ws + WS_QK); const bf16* VT = (const bf16*)(F.ws + WS_VT); bf16* AO = (bf16*)(F.ws + (MODE == 0 ? WS_AO : WS_HID)); const float* KM = (const float*)(F.ws + WS_KMEAN);
    const int tid = F.tid, lane = F.lane, w = F.wave, r32 = lane & 31, hi = lane >> 5;
    const int t0 = j * 256, tq = t0 + 32 * w + r32;
    const bf16* Qrow = QK + (size_t)(b * SEQ + tq) * 4096 + h * HD;
    const bf16* Kb = QK + (size_t)(b * SEQ) * 4096 + 2048 + h * HD;
    const bf16* Vtb = VT + (size_t)(h * HD) * MTOK + b * SEQ;
    bf16x8 qr[8];
#pragma unroll
    for (int ks = 0; ks < 8; ++ks) qr[ks] = *(const GAS bf16x8*)(Qrow + 16 * ks + 8 * hi);
    unsigned selmask = 0u;
    if (MODE == 0 && j > 0) {
        const float* kmrow = KM + ((size_t)((b * NH + h) * NBLK + r32)) * HD;
        f32x16 g = (f32x16){};
#pragma unroll
        for (int ks = 0; ks < 8; ++ks) {
            const f32x4 a = *(const GAS f32x4*)(kmrow + 16 * ks + 8 * hi), c = *(const GAS f32x4*)(kmrow + 16 * ks + 8 * hi + 4);
            const float v[8] = {a.x, a.y, a.z, a.w, c.x, c.y, c.z, c.w}; bf16x8 kh, kl;
#pragma unroll
            for (int e = 0; e < 8; ++e) { const unsigned hb = f2bf(v[e]); kh[e] = (short)hb; kl[e] = (short)f2bf(v[e] - bf2f((unsigned short)hb)); }
            g = MFMA32(kh, qr[ks], g); g = MFMA32(kl, qr[ks], g);
        }
        const float NEG = -__builtin_inff();
        float v[16];
#pragma unroll
        for (int r = 0; r < 16; ++r) { const int n = (r & 3) + 8 * (r >> 2) + 4 * hi; v[r] = (n < j) ? g[r] : NEG; }
#pragma unroll
        for (int it = 0; it < 3; ++it) {
            float lm = NEG; int ln = 0;
#pragma unroll
            for (int r = 0; r < 16; ++r) { const int n = (r & 3) + 8 * (r >> 2) + 4 * hi; if (v[r] > lm) { lm = v[r]; ln = n; } }
            float lmB, lnBf; const float lmA = swap_lo(lm, lmB); const float lnAf = swap_lo((float)ln, lnBf);
            const int lnA = (int)lnAf, lnB = (int)lnBf;
            const bool pickA = (lmA > lmB) || (lmA == lmB && lnA < lnB);
            const float wm = pickA ? lmA : lmB; const int wn = pickA ? lnA : lnB;
            if (wm > NEG) selmask |= 1u << wn;
            const bool mine = (pickA == (hi == 0));
#pragma unroll
            for (int r = 0; r < 16; ++r) { const int n = (r & 3) + 8 * (r >> 2) + 4 * hi; if (mine && n == wn) v[r] = NEG; }
        }
    }
    const float slope2 = exp2f(-0.5f * (float)(h + 1)) * 1.4426950408889634f;
    const float C2 = 0.08838834764831845f * 1.4426950408889634f;
    float m = -1e30f, l = 0.f; f32x16 o[4] = {};
    const int NT = 4 * (j + 1);
    TileRegs T;
    tile_load(T, Kb, Vtb, t0 + 192, tid); tile_store(T, F.lds, 0, tid);
    __syncthreads();
    for (int t = 0; t < NT; ++t) {
        const int kb = t0 + 192 - 64 * t, buf = t & 1;
        if (t + 1 < NT) tile_load(T, Kb, Vtb, kb - 64, tid);
        const int n = kb >> 8;
        bool act, sel = true, needmask = false;
        if (n == j) { act = (kb <= t0 + 32 * w + 31); needmask = (kb + 63 > t0 + 32 * w); }
        else { sel = ((selmask >> n) & 1u) != 0u; act = __any(sel); }
        if (MODE == 1) { if (n == j) { f32x16 p0, p1; qk_tile(p0, p1, F.lds + ATT_K0 + buf * ATT_KB, qr, r32, hi);
#pragma unroll
                for (int r = 0; r < 16; ++r) { p0[r] *= 0.01f; p1[r] *= 0.01f; }
                pv_tile(o, F.lds + ATT_V0 + buf * ATT_VB, p0, p1, r32, hi); l = 0.5f; } }
        else if (act) {
            f32x16 p0, p1;
            qk_tile(p0, p1, F.lds + ATT_K0 + buf * ATT_KB, qr, r32, hi);
            const float NEG = -__builtin_inff();
            const float base = slope2 * (float)(kb + 4 * hi - tq);
            const float T0 = sel ? base : NEG, T1 = sel ? base + 32.0f * slope2 : NEG;
            const int dq = tq - kb - 4 * hi;
            float mx0 = NEG, mx1 = NEG;
#pragma unroll
            for (int r = 0; r < 16; ++r) { const int c = (r & 3) + 8 * (r >> 2); const float bc = slope2 * (float)c;
                float x0 = fmaf(p0[r], C2, bc), x1 = fmaf(p1[r], C2, bc);
                if (needmask) { if (c > dq) x0 = NEG; if (c + 32 > dq) x1 = NEG; }
                p0[r] = x0; p1[r] = x1; mx0 = fmaxf(mx0, x0); mx1 = fmaxf(mx1, x1); }
            float cand = fmaxf(mx0 + T0, mx1 + T1);
            { float cb; const float ca = swap_lo(cand, cb); cand = fmaxf(ca, cb); }
            if (__any(cand > m + 8.0f)) {
                const float mn = fmaxf(m, cand), alpha = __builtin_amdgcn_exp2f(m - mn);
                l *= alpha; m = mn;
#pragma unroll
                for (int db = 0; db < 4; ++db)
#pragma unroll
                    for (int r = 0; r < 16; ++r) o[db][r] *= alpha;
            }
            const float d0 = T0 - m, d1 = T1 - m; float ps = 0.f;
#pragma unroll
            for (int r = 0; r < 16; ++r) { p0[r] = __builtin_amdgcn_exp2f(p0[r] + d0); p1[r] = __builtin_amdgcn_exp2f(p1[r] + d1); ps += p0[r] + p1[r]; }
            l += ps;
            pv_tile(o, F.lds + ATT_V0 + buf * ATT_VB, p0, p1, r32, hi);
        }
        if (t + 1 < NT) tile_store(T, F.lds, buf ^ 1, tid);
        __syncthreads();
    }
    { float lb; const float la = swap_lo(l, lb); l = la + lb; }
    store_ot(o, 1.0f / l, AO + (size_t)(b * SEQ + tq) * DM + h * HD, hi);
}

__device__ __forceinline__ void sb_unit(Frame& F, int b, int h, int qb) {
    const bf16* QK = (const bf16*)(F.ws + WS_QK); const bf16* VT = (const bf16*)(F.ws + WS_VT); bf16* AO = (bf16*)(F.ws + WS_AO);
    const int tid = F.tid, lane = F.lane, w = F.wave, r32 = lane & 31, hi = lane >> 5;
    const int t0 = qb * 256, tq = t0 + 32 * w + r32;
    const bf16* Qrow = QK + (size_t)(b * SEQ + tq) * 4096 + h * HD;
    const bf16* Kb = QK + (size_t)(b * SEQ) * 4096 + 2048 + h * HD;
    const bf16* Vtb = VT + (size_t)(h * HD) * MTOK + b * SEQ;
    bf16x8 qr[8];
#pragma unroll
    for (int ks = 0; ks < 8; ++ks) qr[ks] = *(const GAS bf16x8*)(Qrow + 16 * ks + 8 * hi);
    const float C2 = 0.08838834764831845f * 1.4426950408889634f;
    float R = 0.f; f32x16 o[4] = {}; bool done = false;
    volatile LAS unsigned* flags = (volatile LAS unsigned*)(F.lds + ATT_FLAGS);
    TileRegs T;
    const int ktop = 4 * qb + 3;
    tile_load(T, Kb, Vtb, 64 * ktop, tid); tile_store(T, F.lds, 0, tid);
    __syncthreads();
    for (int it = 0;; ++it) {
        const int kb = 64 * (ktop - it), buf = it & 1; const bool more = kb > 0;
        if (more) tile_load(T, Kb, Vtb, kb - 64, tid);
        const bool act = !done && (kb < t0 + 32 * w + 31);
        if (act) {
            const bool needmask = (kb + 63 >= t0 + 32 * w);
            f32x16 p0, p1;
            qk_tile(p0, p1, F.lds + ATT_K0 + buf * ATT_KB, qr, r32, hi);
            const int dq = tq - kb - 4 * hi;
            f32x16 k0, k1;
            float s0[4], s1[4];
#pragma unroll
            for (int g = 0; g < 4; ++g) { s0[g] = 0.f; s1[g] = 0.f; }
#pragma unroll
            for (int r = 0; r < 16; ++r) { const int c = (r & 3) + 8 * (r >> 2);
                const float u0 = p0[r] * C2, u1 = p1[r] * C2;
                float a0 = fminf(-u0, 0.f) - __builtin_amdgcn_logf(1.0f + __builtin_amdgcn_exp2f(-fabsf(u0)));
                float a1 = fminf(-u1, 0.f) - __builtin_amdgcn_logf(1.0f + __builtin_amdgcn_exp2f(-fabsf(u1)));
                if (needmask) { if (!(c < dq)) a0 = 0.f; if (!(c + 32 < dq)) a1 = 0.f; }
                p0[r] = u0; p1[r] = u1; k0[r] = a0; k1[r] = a1; s0[r >> 2] += a0; s1[r >> 2] += a1; }
            float run = R, off0[4], off1[4];
#pragma unroll
            for (int g = 3; g >= 0; --g) { float sb; const float sa = swap_lo(s1[g], sb); const float o_hi1 = run; run += sb; const float o_hi0 = run; run += sa; off1[g] = hi ? o_hi1 : o_hi0; }
#pragma unroll
            for (int g = 3; g >= 0; --g) { float sb; const float sa = swap_lo(s0[g], sb); const float o_hi1 = run; run += sb; const float o_hi0 = run; run += sa; off0[g] = hi ? o_hi1 : o_hi0; }
            R = run;
#pragma unroll
            for (int g = 0; g < 4; ++g) { float c0 = off0[g], c1 = off1[g];
#pragma unroll
                for (int i = 3; i >= 0; --i) { const int r = 4 * g + i, c = (r & 3) + 8 * (r >> 2);
                    c0 += k0[r]; c1 += k1[r];
                    float w0 = __builtin_amdgcn_exp2f(p0[r] + c0), w1 = __builtin_amdgcn_exp2f(p1[r] + c1);
                    if (needmask) { if (!(c < dq)) w0 = 0.f; if (!(c + 32 < dq)) w1 = 0.f; }
                    p0[r] = w0; p1[r] = w1; } }
            pv_tile(o, F.lds + ATT_V0 + buf * ATT_VB, p0, p1, r32, hi);
            done = __all(R < -152.0f);
        }
        if (lane == 0) flags[(it & 1) * 8 + w] = done ? 1u : 0u;
        if (more) tile_store(T, F.lds, buf ^ 1, tid);
        __syncthreads();
        unsigned nd = 0;
#pragma unroll
        for (int i = 0; i < 8; ++i) nd += flags[(it & 1) * 8 + i];
        if (nd == 8u || !more) break;
    }
    store_ot(o, 1.0f, AO + (size_t)(b * SEQ + tq) * DM + h * HD, hi);
    __syncthreads();
}

__device__ __forceinline__ void router_phase(Frame& F) {
    const float* H = (const float*)(F.ws + WS_H); bf16* Y = (bf16*)(F.ws + WS_Y);
    int* TOKE = (int*)(F.ws + WS_TOKE); float* TOKG = (float*)(F.ws + WS_TOKG); int* TOKR = (int*)(F.ws + WS_TOKR); int* CNT = (int*)(F.ws + WS_CNT);
    LAS float* wl = (LAS float*)F.lds;
    LAS int* te = (LAS int*)(F.lds + 65536);
    { const GAS f32x4* src = (const GAS f32x4*)(F.ws + WS_WRG); LAS f32x4* dst = (LAS f32x4*)wl; for (int i = F.tid; i < NE * DM / 4; i += NWAVES * 64) dst[i] = src[i]; }
    __syncthreads();
    const int rows_per_wg = MTOK / F.G, rows_per_wave = rows_per_wg / NWAVES;
    const int row0 = F.vcu * rows_per_wg + F.wave * rows_per_wave;
    for (int i = 0; i < rows_per_wave; ++i) {
        const int m = row0 + i;
        const GAS f32x4* xr = (const GAS f32x4*)(H + (size_t)m * DM) + F.lane;
        f32x4 v[8]; float s = 0.f;
#pragma unroll
        for (int j = 0; j < 8; ++j) { v[j] = xr[64 * j]; s += (v[j].x * v[j].x + v[j].y * v[j].y) + (v[j].z * v[j].z + v[j].w * v[j].w); }
        const float r = 1.0f / sqrtf(wave_sum(s) * (1.0f / DM) + RMS_EPS);
        GAS unsigned long long* o8 = (GAS unsigned long long*)(Y + (size_t)m * DM) + F.lane;
#pragma unroll
        for (int j = 0; j < 8; ++j) o8[64 * j] = (unsigned long long)cvtpk(v[j].x * r, v[j].y * r) | ((unsigned long long)cvtpk(v[j].z * r, v[j].w * r) << 32);
        float lg[NE];
#pragma unroll
        for (int e = 0; e < NE; ++e) { float a = 0.f;
#pragma unroll
            for (int j = 0; j < 8; ++j) { const f32x4 wv = *(const LAS f32x4*)(wl + e * DM + 256 * j + 4 * F.lane); a += (v[j].x * wv.x + v[j].y * wv.y) + (v[j].z * wv.z + v[j].w * wv.w); }
            lg[e] = wave_sum(a) * r; }
        int i0 = 0; float l0 = lg[0];
#pragma unroll
        for (int e = 1; e < NE; ++e) if (lg[e] > l0) { l0 = lg[e]; i0 = e; }
        int i1 = -1; float l1 = -__builtin_inff();
#pragma unroll
        for (int e = 0; e < NE; ++e) if (e != i0 && lg[e] > l1) { l1 = lg[e]; i1 = e; }
        const float ex = expf(l1 - l0), g0 = 1.0f / (1.0f + ex), g1 = ex / (1.0f + ex);
        if (F.lane == 0) { TOKE[2 * m] = i0; TOKE[2 * m + 1] = i1; TOKG[2 * m] = g0; TOKG[2 * m + 1] = g1; const int lr = m - F.vcu * rows_per_wg; te[2 * lr] = i0; te[2 * lr + 1] = i1; }
    }
    __syncthreads();
    if (F.tid < NE) { int c = 0; const int mb = F.vcu * rows_per_wg;
        for (int t = 0; t < rows_per_wg; ++t) {
#pragma unroll
            for (int k = 0; k < 2; ++k) if (te[2 * t + k] == F.tid) { TOKR[2 * (mb + t) + k] = c; ++c; } }
        CNT[F.vcu * NE + F.tid] = c; }
    __syncthreads();
}
__device__ __forceinline__ void scatter_phase(Frame& F) {
    const bf16* Y = (const bf16*)(F.ws + WS_Y); bf16* XS = (bf16*)(F.ws + WS_XS);
    const int* TOKE = (const int*)(F.ws + WS_TOKE); const int* TOKR = (const int*)(F.ws + WS_TOKR); int* TOKP = (int*)(F.ws + WS_TOKP); const int* CNT = (const int*)(F.ws + WS_CNT); int* META = (int*)(F.ws + WS_META);
    LAS int* cl = (LAS int*)F.lds;
    LAS int* tot = (LAS int*)(F.lds + 16384);
    for (int i = F.tid; i < F.G * NE; i += NWAVES * 64) cl[i] = CNT[i];
    __syncthreads();
    if (F.tid < NE) { int t = 0, p = 0; for (int g = 0; g < F.G; ++g) { const int c = cl[g * NE + F.tid]; if (g < F.vcu) p += c; t += c; } tot[F.tid] = t; tot[8 + F.tid] = p; }
    __syncthreads();
    if (F.tid == 0) { int ts = 0; for (int e = 0; e < NE; ++e) { tot[16 + e] = ts; tot[32 + e] = ts * 256 + tot[8 + e]; ts += (tot[e] + 255) / 256; } tot[16 + NE] = ts;
        if (F.vcu == 0) { for (int e = 0; e <= NE; ++e) META[e] = tot[16 + e]; } }
    __syncthreads();
    const int rows_per_wg = MTOK / F.G, rows_per_wave = rows_per_wg / NWAVES;
    const int row0 = F.vcu * rows_per_wg + F.wave * rows_per_wave;
    for (int i = 0; i < rows_per_wave; ++i) { const int m = row0 + i;
        const GAS v4u* src = (const GAS v4u*)(Y + (size_t)m * DM) + F.lane;
        v4u v[4];
#pragma unroll
        for (int j = 0; j < 4; ++j) v[j] = src[64 * j];
#pragma unroll
        for (int k = 0; k < 2; ++k) { const int e = TOKE[2 * m + k], pos = tot[32 + e] + TOKR[2 * m + k];
            if (F.lane == 0) TOKP[2 * m + k] = pos;
            GAS v4u* dst = (GAS v4u*)(XS + (size_t)pos * DM) + F.lane;
#pragma unroll
            for (int j = 0; j < 4; ++j) dst[64 * j] = v[j]; } }
    __syncthreads();
}
__device__ __forceinline__ void combine_phase(Frame& F) {
    const float* H = (const float*)(F.ws + WS_H); const float* YS = (const float*)(F.ws + WS_YS); const int* TOKP = (const int*)(F.ws + WS_TOKP); const float* TOKG = (const float*)(F.ws + WS_TOKG);
    const float* gf = F.in[16];
    const int gw = F.vcu * NWAVES + F.wave, NGW = F.G * NWAVES;
    for (int m = gw; m < MTOK; m += NGW) {
        const int p0 = TOKP[2 * m], p1 = TOKP[2 * m + 1]; const float g0 = TOKG[2 * m], g1 = TOKG[2 * m + 1];
        const GAS f32x4* xr = (const GAS f32x4*)(H + (size_t)m * DM) + F.lane; const GAS f32x4* y0 = (const GAS f32x4*)(YS + (size_t)p0 * DM) + F.lane; const GAS f32x4* y1 = (const GAS f32x4*)(YS + (size_t)p1 * DM) + F.lane;
        f32x4 v[8]; float s = 0.f;
#pragma unroll
        for (int j = 0; j < 8; ++j) { v[j] = xr[64 * j] + (y0[64 * j] * g0 + y1[64 * j] * g1); s += (v[j].x * v[j].x + v[j].y * v[j].y) + (v[j].z * v[j].z + v[j].w * v[j].w); }
        const float r = 1.0f / sqrtf(wave_sum(s) * (1.0f / DM) + RMS_EPS);
        GAS f32x4* orow = (GAS f32x4*)(F.out + (size_t)m * DM) + F.lane; const GAS f32x4* gr = (const GAS f32x4*)gf + F.lane;
#pragma unroll
        for (int j = 0; j < 8; ++j) orow[64 * j] = v[j] * r * gr[64 * j];
    }
}

struct Args { const float* in[17]; float* out; unsigned char* ws; int ph_lo, ph_hi; };
__global__ void __launch_bounds__(NWAVES * 64, 2) yoco_fwd(Args args) {
    extern __shared__ __attribute__((aligned(16))) unsigned char lds[];
    Frame F;
    F.lds = (LAS unsigned char*)lds;
    F.MISC = (volatile LAS unsigned*)(F.lds + MISC_OFF);
    F.tid = threadIdx.x; F.lane = F.tid & 63; F.wave = __builtin_amdgcn_readfirstlane(F.tid >> 6);
    F.G = gridDim.x; { const int bx = blockIdx.x; F.vcu = (F.G % 8 == 0) ? (bx % 8) * (F.G / 8) + bx / 8 : bx; }
    unsigned char* ws = args.ws; F.ws = ws; F.out = args.out;
#pragma unroll
    for (int i = 0; i < 17; ++i) F.in[i] = args.in[i];
    F.ctl = (gu32*)(ws + WS_CTL);
    for (int u = F.tid; u < (LDS_BYTES - MISC_OFF) / 4; u += NWAVES * 64) ((LAS unsigned*)(F.lds + MISC_OFF))[u] = 0u;
    __syncthreads();
    XcdBarrier bar; bar.bar = (unsigned*)(F.ctl + CW_BAR); bar.x = 0; bar.st = nullptr;
    if (N_LAUNCHES == 1) bar = xcd_barrier_post((unsigned*)(F.ctl + CW_BAR), F.MISC + 8);
#define GRID_BAR() do { if (N_LAUNCHES == 1) { xcd_barrier(bar); } } while (0)
    const int lo = args.ph_lo, hi = args.ph_hi;
#if defined(DBG) && DBG
    if (lo == 1202) { const int bx = blockIdx.x; moba_unit<1>(F, bx & 1, (bx >> 1) % NH, (bx >> 5) & 7); return; }
    if (lo >= 1000) { dbg_check(F, lo - 1000); return; }
#endif
#define IN(k) (lo <= (k) && (k) < hi)
#define SEAM(k) do { if (IN(k) && IN((k) + 1)) GRID_BAR(); } while (0)
    LAS unsigned char* ring = F.lds;
    const int cid = (int)blockIdx.x;

    if (IN(0)) { p0_prologue(F); } SEAM(0);
    if (IN(1)) {
        { pg8::Gemm g{(const bf16*)(ws + WS_Y), (const bf16*)(ws + WS_WQK0), MTOK, 4096, DM}; pg8::StaticOrder S; S.init(MTOK, 4096, F.G, cid);
          pg8::EpiBf16 E{(bf16*)(ws + WS_QK), 4096}; pg8::gemm_phase<pg8::EpiBf16, pg8::StaticOrder, true, true>(ring, g, S, E); }
        { pg8::Gemm g{(const bf16*)(ws + WS_WV0), (const bf16*)(ws + WS_Y), DM, MTOK, DM}; pg8::StaticOrder S; S.init(DM, MTOK, F.G, cid);
          pg8::EpiBf16 E{(bf16*)(ws + WS_VT), MTOK}; pg8::gemm_phase<pg8::EpiBf16, pg8::StaticOrder, true, true>(ring, g, S, E); }
    } SEAM(1);
    if (IN(2)) { kmean_phase(F); } SEAM(2);
    if (IN(3)) {
        for (int i = 0; i < 4; ++i) { const int v = F.vcu; if (v >= BATCH * NH * 8) break; const int s = v & 7, bh = v >> 3; const int j = (i == 0) ? s : (i == 1) ? 15 - s : (i == 2) ? 16 + s : 31 - s;
            moba_unit<0>(F, bh / NH, bh % NH, j); }
    } SEAM(3);
    if (IN(4)) {
        pg8::Gemm g{(const bf16*)(ws + WS_AO), (const bf16*)(ws + WS_WO0), MTOK, DM, DM}; pg8::StaticOrder S; S.init(MTOK, DM, F.G, cid);
        pg8::EpiResF32 E{F.in[0], (float*)(ws + WS_H), DM}; pg8::gemm_phase<pg8::EpiResF32, pg8::StaticOrder, true, true>(ring, g, S, E);
    } SEAM(4);
    if (IN(5)) { norm_rows(F, (const float*)(ws + WS_H), (bf16*)(ws + WS_Y)); } SEAM(5);
    if (IN(6)) {
        pg8::Gemm g{(const bf16*)(ws + WS_Y), (const bf16*)(ws + WS_W13D), MTOK, 2 * FFD, DM}; pg8::StaticOrder S; S.init(MTOK, 2 * FFD, F.G, cid);
        pg8::EpiSwiGLU E{(bf16*)(ws + WS_HID), FFD}; pg8::gemm_phase<pg8::EpiSwiGLU, pg8::StaticOrder, true, true>(ring, g, S, E);
    } SEAM(6);
    if (IN(7)) {
        pg8::Gemm g{(const bf16*)(ws + WS_HID), (const bf16*)(ws + WS_W2D), MTOK, DM, FFD}; pg8::StaticOrder S; S.init(MTOK, DM, F.G, cid);
        pg8::EpiResF32 E{(const float*)(ws + WS_H), (float*)(ws + WS_H), DM}; pg8::gemm_phase<pg8::EpiResF32, pg8::StaticOrder, true, true>(ring, g, S, E);
    } SEAM(7);
    if (IN(8)) { norm_rows(F, (const float*)(ws + WS_H), (bf16*)(ws + WS_Y)); } SEAM(8);
    if (IN(9)) {
        { pg8::Gemm g{(const bf16*)(ws + WS_Y), (const bf16*)(ws + WS_WQK1), MTOK, 4096, DM}; pg8::StaticOrder S; S.init(MTOK, 4096, F.G, cid);
          pg8::EpiBf16 E{(bf16*)(ws + WS_QK), 4096}; pg8::gemm_phase<pg8::EpiBf16, pg8::StaticOrder, true, true>(ring, g, S, E); }
        { pg8::Gemm g{(const bf16*)(ws + WS_WV1), (const bf16*)(ws + WS_Y), DM, MTOK, DM}; pg8::StaticOrder S; S.init(DM, MTOK, F.G, cid);
          pg8::EpiBf16 E{(bf16*)(ws + WS_VT), MTOK}; pg8::gemm_phase<pg8::EpiBf16, pg8::StaticOrder, true, true>(ring, g, S, E); }
    } SEAM(9);
    if (IN(10)) {
        for (int i = 0; i < 4; ++i) { const int v = F.vcu; if (v >= BATCH * NH * 8) break; sb_unit(F, (v >> 3) / NH, (v >> 3) % NH, (v & 7) + 8 * i); }
    } SEAM(10);
    if (IN(11)) {
        pg8::Gemm g{(const bf16*)(ws + WS_AO), (const bf16*)(ws + WS_WO1), MTOK, DM, DM}; pg8::StaticOrder S; S.init(MTOK, DM, F.G, cid);
        pg8::EpiResF32 E{(const float*)(ws + WS_H), (float*)(ws + WS_H), DM}; pg8::gemm_phase<pg8::EpiResF32, pg8::StaticOrder, true, true>(ring, g, S, E);
    } SEAM(11);
    if (IN(12)) { router_phase(F); } SEAM(12);
    if (IN(13)) { scatter_phase(F); } SEAM(13);
    if (IN(14)) {
        const int* META = (const int*)(ws + WS_META); const int P = META[8];
        pg8::Gemm g{(const bf16*)(ws + WS_XS), (const bf16*)(ws + WS_W13M), P * 256, 2 * FFE, DM};
        pg8::MoeOrder S; S.so.init(P * 256, 2 * FFE, F.G, cid); S.t1 = META[1]; S.t2 = META[2]; S.t3 = META[3]; S.t4 = META[4]; S.t5 = META[5]; S.t6 = META[6]; S.t7 = META[7]; S.estride = (size_t)2 * FFE * DM * 2;
        pg8::EpiSwiGLU E{(bf16*)(ws + WS_HID), FFE}; pg8::gemm_phase<pg8::EpiSwiGLU, pg8::MoeOrder, true, true>(ring, g, S, E);
    } SEAM(14);
    if (IN(15)) {
        const int* META = (const int*)(ws + WS_META); const int P = META[8];
        pg8::Gemm g{(const bf16*)(ws + WS_HID), (const bf16*)(ws + WS_W2M), P * 256, DM, FFE};
        pg8::MoeOrder S; S.so.init(P * 256, DM, F.G, cid); S.t1 = META[1]; S.t2 = META[2]; S.t3 = META[3]; S.t4 = META[4]; S.t5 = META[5]; S.t6 = META[6]; S.t7 = META[7]; S.estride = (size_t)DM * FFE * 2;
        pg8::EpiResF32 E{nullptr, (float*)(ws + WS_YS), DM}; pg8::gemm_phase<pg8::EpiResF32, pg8::MoeOrder, true, true>(ring, g, S, E);
    } SEAM(15);
    if (IN(16)) { combine_phase(F); }
#undef IN
#undef SEAM
#undef GRID_BAR
}

extern "C" void kernel_launch(void* const* d_in, const int* in_sizes, int n_in, void* d_out, int out_size, void* d_ws, size_t ws_size, hipStream_t stream) {
    static int grid = 0;
    if (grid == 0) {
        if (n_in != 17 || in_sizes[0] != MTOK * DM || out_size != MTOK * DM || ws_size < WS_END) { fprintf(stderr, "kernel_launch: unexpected shapes (n_in %d, in0 %d, out %d, ws %zu < %zu); nothing launched\n", n_in, n_in > 0 ? in_sizes[0] : -1, out_size, ws_size, (size_t)WS_END); grid = -1; return; }
        int dev = 0, cus = 0, per_cu = 0;
        if (hipGetDevice(&dev) != hipSuccess || hipDeviceGetAttribute(&cus, hipDeviceAttributeMultiprocessorCount, dev) != hipSuccess) { fprintf(stderr, "kernel_launch: device query failed\n"); grid = -1; return; }
        if (hipFuncSetAttribute((const void*)yoco_fwd, hipFuncAttributeMaxDynamicSharedMemorySize, LDS_BYTES) != hipSuccess) { fprintf(stderr, "kernel_launch: hipFuncSetAttribute failed\n"); grid = -1; return; }
        if (hipOccupancyMaxActiveBlocksPerMultiprocessor(&per_cu, (const void*)yoco_fwd, NWAVES * 64, LDS_BYTES) != hipSuccess || per_cu < 1) fprintf(stderr, "kernel_launch: note: occupancy query reports %d workgroups per CU\n", per_cu);
        (void)hipGetLastError();
        grid = cus;
        if (grid != 256) fprintf(stderr, "kernel_launch: %d CUs; this kernel is laid out for 256\n", grid);
    }
    if (grid < 0) return;
    if (hipMemsetAsync((char*)d_ws + WS_CTL, 0, CTL_ZERO_BYTES, stream) != hipSuccess) { fprintf(stderr, "kernel_launch: memset failed\n"); return; }
    Args a{};
    for (int i = 0; i < 17; ++i) a.in[i] = (const float*)d_in[i];
    a.out = (float*)d_out; a.ws = (unsigned char*)d_ws;
    for (int li = 0; li < N_LAUNCHES; ++li) {
#if defined(DBG) && DBG
        if (li == 4 || li == 7 || li == 11) { a.ph_lo = 1000 + li + 49; a.ph_hi = a.ph_lo + 1; hipLaunchKernelGGL(yoco_fwd, dim3(grid), dim3(NWAVES * 64), LDS_BYTES, stream, a); }
#endif
        a.ph_lo = (N_LAUNCHES == 1) ? 0 : li; a.ph_hi = (N_LAUNCHES == 1) ? NPHASE : li + 1;
        hipLaunchKernelGGL(yoco_fwd, dim3(grid), dim3(NWAVES * 64), LDS_BYTES, stream, a);
#if defined(DBG) && DBG
        if (li == 1) { for (int q = 1201; q <= 1203; ++q) { a.ph_lo = q; a.ph_hi = q + 1; hipLaunchKernelGGL(yoco_fwd, dim3(grid), dim3(NWAVES * 64), LDS_BYTES, stream, a); } }
        { a.ph_lo = 1000 + li; a.ph_hi = a.ph_lo + 1; hipLaunchKernelGGL(yoco_fwd, dim3(grid), dim3(NWAVES * 64), LDS_BYTES, stream, a);
          if (li == NPHASE - 1) { a.ph_lo = 1099; a.ph_hi = 1100; hipLaunchKernelGGL(yoco_fwd, dim3(grid), dim3(NWAVES * 64), LDS_BYTES, stream, a); } }
#endif
        const hipError_t le = hipPeekAtLastError();
        if (le != hipSuccess) { fprintf(stderr, "kernel_launch: launch %d failed: %s\n", li, hipGetErrorName(le)); break; }
    }
}
```

```cpp
#include <hip/hip_runtime.h>
#include <cstdio>
#include <cstdint>
__device__ __forceinline__ int lane_id_fresh() { int l; asm volatile("v_mbcnt_lo_u32_b32 %0, -1, 0\n\tv_mbcnt_hi_u32_b32 %0, -1, %0" : "=v"(l)); return l; }
__device__ __forceinline__ int lane_id() { return (int)__builtin_amdgcn_mbcnt_hi(~0u, __builtin_amdgcn_mbcnt_lo(~0u, 0u)); }
namespace pg8 {
#define PG8_LAS __attribute__((address_space(3)))
typedef unsigned short bf16_t;
typedef short bf16x8 __attribute__((ext_vector_type(8)));
typedef float f32x4 __attribute__((ext_vector_type(4)));
typedef unsigned u32x4 __attribute__((ext_vector_type(4)));
constexpr int BM = 256, BK = 64, HALF = 128, HTB = HALF * BK * 2  , STAGE_BYTES = 8 * HTB, NXCD = 8, WGM = 8;

__host__ __device__ __forceinline__ int lds_byte(int r, int c) { const int st = (r >> 4) * 2 + (c >> 5), rr = r & 15, cc = c & 31, ob = rr * 64 + cc * 2; return st * 1024 + (ob ^ (((ob >> 9) & 1) << 5)); }
__host__ __device__ __forceinline__ void stage_rc(int b, int& R, int& C) { const int st = b / 1024, sb = b % 1024, swz = sb ^ (((sb >> 9) & 1) << 5); R = (st >> 1) * 16 + swz / 64; C = (st & 1) * 32 + (swz % 64) / 2; }
__host__ __device__ __forceinline__ int perm32(int rho) { const int n = rho >> 4, i = rho & 15; return 8 * (i >> 2) + 4 * n + (i & 3); }

struct Unit { int pm, pn; size_t boff; int slot; };
struct Gemm { const bf16_t* A; const bf16_t* Bt; int M, N, K; };

struct StaticOrder {
    int nM, nN, nwg, G, c;
    __host__ __device__ void init(int M, int N, int G_, int c_) { nM = M / BM; nN = N / BM; nwg = nM * nN; G = G_; c = c_; }
    static constexpr bool SPLITK = false;
    __host__ __device__ bool next(int i, Unit& u) const { return at((long)i * G + c, u); }
    __host__ __device__ bool at(const long L, Unit& u) const {
        if (L >= nwg) return false;
        int wgid = (int)L; { const int q = nwg / NXCD, r = nwg % NXCD, xcd = wgid % NXCD, off = wgid / NXCD; wgid = (xcd < r ? xcd * (q + 1) : r * (q + 1) + (xcd - r) * q) + off; }
        const int nig = WGM * nN, gid = wgid / nig, fm = gid * WGM, gsz = (nM - fm) < WGM ? (nM - fm) : WGM;
        u.pm = fm + ((wgid % nig) % gsz); u.pn = (wgid % nig) / gsz; u.boff = 0;
#if defined(__HIP_DEVICE_COMPILE__)
        u.pm = __builtin_amdgcn_readfirstlane(u.pm); u.pn = __builtin_amdgcn_readfirstlane(u.pn);
#endif
        return true;
    }
    __device__ __forceinline__ void a_ready(const Unit&) const {}
    __device__ __forceinline__ void done(const Unit&) const {}
};
struct MoeOrder {
    static constexpr bool SPLITK = false;
    StaticOrder so; int t1, t2, t3, t4, t5, t6, t7; size_t estride;
    __device__ bool next(int i, Unit& u) const { return at((long)i * so.G + so.c, u); }
    __device__ bool at(const long L, Unit& u) const {
        if (!so.at(L, u)) return false;
        const int e = __builtin_amdgcn_readfirstlane((u.pm >= t1) + (u.pm >= t2) + (u.pm >= t3) + (u.pm >= t4) + (u.pm >= t5) + (u.pm >= t6) + (u.pm >= t7));
        u.boff = (size_t)e * estride; return true;
    }
    __device__ __forceinline__ void a_ready(const Unit&) const {}
    __device__ __forceinline__ void done(const Unit&) const {}
};
template <int NT_FULL, int KQ_BYTES> struct MoeTailOrder {
    static constexpr bool SPLITK = true;
    MoeOrder mo;
    static __device__ __forceinline__ unsigned koff(const Unit& u) { return u.slot < 0 ? 0u : (unsigned)(u.slot & 3) * (unsigned)KQ_BYTES; }
    static __device__ __forceinline__ int ntile(const Unit& u) { return u.slot < 0 ? NT_FULL : NT_FULL / 4; }
    __device__ bool next(int i, Unit& u) const {
        const int G = mo.so.G, c = mo.so.c, full = mo.so.nwg / G;
        u.slot = -1;
        if (i < full) return mo.at((long)i * G + c, u);
        if (i > full) return false;
        const int tpx = (mo.so.nwg - full * G) / NXCD;
        if (G != 256 || (mo.so.nwg % NXCD) != 0 || tpx > 8) return mo.at((long)i * G + c, u);
        const int x = c % NXCD, j = c / NXCD, tu = j >> 2, ks = j & 3;
        if (tu >= tpx) return false;
        if (!mo.at((long)full * G + tu * NXCD + x, u)) return false;
        u.slot = (x * 8 + tu) * 4 + ks;
#if defined(__HIP_DEVICE_COMPILE__)
        u.slot = __builtin_amdgcn_readfirstlane(u.slot);
#endif
        return true;
    }
    __device__ __forceinline__ void a_ready(const Unit&) const {}
    __device__ __forceinline__ void done(const Unit&) const {}
};

__device__ __forceinline__ unsigned cvt_pk_bf16(float lo, float hi) { unsigned r; asm volatile("v_cvt_pk_bf16_f32 %0, %1, %2" : "=v"(r) : "v"(lo), "v"(hi)); return r; }
typedef int v8i_t __attribute__((ext_vector_type(8)));
typedef int v4i_t __attribute__((ext_vector_type(4)));
__device__ __forceinline__ v8i_t cat8(bf16x8 lo, bf16x8 hi) { const v4i_t a = __builtin_bit_cast(v4i_t, lo), b = __builtin_bit_cast(v4i_t, hi); return __builtin_shufflevector(a, b, 0, 1, 2, 3, 4, 5, 6, 7); }
__device__ __forceinline__ float clamp448(float x) { return __builtin_fminf(__builtin_fmaxf(x, -448.0f), 448.0f); }
__device__ __forceinline__ unsigned pk4_fp8(float a, float b, float c, float d) { int w = 0; w = __builtin_amdgcn_cvt_pk_fp8_f32(clamp448(a), clamp448(b), w, false); w = __builtin_amdgcn_cvt_pk_fp8_f32(clamp448(c), clamp448(d), w, true); return (unsigned)w; }
struct EpiBf16 {
    static constexpr bool PERM = true, AFTER_DRAIN = false;
    bf16_t* O; int ldc;
    __device__ __forceinline__ void operator()(const f32x4 (&acc)[2][2][4][2], const Unit& u, int wr, int wc, int fr, int fq) const {
        const int row0 = u.pm * BM + wr * 64 + fr, col0 = u.pn * BM + wc * 32 + 8 * fq;
#pragma unroll
        for (int ai = 0; ai < 2; ++ai)
#pragma unroll
            for (int m = 0; m < 4; ++m) { bf16_t* rowp = O + (size_t)(row0 + ai * HALF + m * 16) * ldc + col0;
#pragma unroll
                for (int bj = 0; bj < 2; ++bj) { const f32x4 v0 = acc[ai][bj][m][0], v1 = acc[ai][bj][m][1];
                    u32x4 w; w.x = cvt_pk_bf16(v0[0], v0[1]); w.y = cvt_pk_bf16(v0[2], v0[3]); w.z = cvt_pk_bf16(v1[0], v1[1]); w.w = cvt_pk_bf16(v1[2], v1[3]);
                    *(u32x4*)(rowp + bj * HALF) = w; } }
    }
};
struct EpiBf16Kmean {
    static constexpr bool PERM = true, AFTER_DRAIN = false;
    bf16_t* O; int ldc; float* KM;
    __device__ __forceinline__ void operator()(const f32x4 (&acc)[2][2][4][2], const Unit& u, int wr, int wc, int fr, int fq) const {
        const int row0 = u.pm * BM + wr * 64 + fr, col0 = u.pn * BM + wc * 32 + 8 * fq;
#pragma unroll
        for (int ai = 0; ai < 2; ++ai)
#pragma unroll
            for (int m = 0; m < 4; ++m) { bf16_t* rowp = O + (size_t)(row0 + ai * HALF + m * 16) * ldc + col0;
#pragma unroll
                for (int bj = 0; bj < 2; ++bj) { const f32x4 v0 = acc[ai][bj][m][0], v1 = acc[ai][bj][m][1];
                    u32x4 w; w.x = cvt_pk_bf16(v0[0], v0[1]); w.y = cvt_pk_bf16(v0[2], v0[3]); w.z = cvt_pk_bf16(v1[0], v1[1]); w.w = cvt_pk_bf16(v1[2], v1[3]);
                    *(u32x4*)(rowp + bj * HALF) = w; } }
        if (u.pn >= 8) {
#pragma unroll
            for (int bj = 0; bj < 2; ++bj) {
                f32x4 s0 = {0.f, 0.f, 0.f, 0.f}, s1 = s0;
#pragma unroll
                for (int ai = 0; ai < 2; ++ai)
#pragma unroll
                    for (int m = 0; m < 4; ++m) { s0 += acc[ai][bj][m][0]; s1 += acc[ai][bj][m][1]; }
                float cs[8] = {s0[0], s0[1], s0[2], s0[3], s1[0], s1[1], s1[2], s1[3]};
#pragma unroll
                for (int j = 0; j < 8; ++j) {
#pragma unroll
                    for (int o = 1; o < 16; o <<= 1) cs[j] += __shfl_xor(cs[j], o);
                }
                if (fr == 0) { const int col = (u.pn - 8) * BM + bj * HALF + wc * 32 + 8 * fq;
                    float* dst = KM + ((size_t)(((u.pm >> 5) * 16 + (col >> 7)) * 32 + (u.pm & 31)) * 128 + (col & 127));
#pragma unroll
                    for (int j = 0; j < 8; ++j) unsafeAtomicAdd(dst + j, cs[j] * (1.0f / 256.0f)); }
            }
        }
    }
};
struct EpiResF32 {
    static constexpr bool PERM = false, AFTER_DRAIN = false;
    const float* base; float* C; int ldc; float scale;
    __device__ __forceinline__ void operator()(const f32x4 (&acc)[2][2][4][2], const Unit& u, int wr, int wc, int fr, int fq) const {
        const int row0 = u.pm * BM + wr * 64 + fr, col0 = u.pn * BM + wc * 32 + 4 * fq;
#pragma unroll
        for (int ai = 0; ai < 2; ++ai)
#pragma unroll
            for (int m = 0; m < 4; ++m) { const size_t off = (size_t)(row0 + ai * HALF + m * 16) * ldc + col0;
                f32x4 r[2][2];
#pragma unroll
                for (int bj = 0; bj < 2; ++bj)
#pragma unroll
                    for (int n = 0; n < 2; ++n) r[bj][n] = base ? *(const f32x4*)(base + off + bj * HALF + n * 16) : (f32x4){0.f, 0.f, 0.f, 0.f};
#pragma unroll
                for (int bj = 0; bj < 2; ++bj)
#pragma unroll
                    for (int n = 0; n < 2; ++n) *(f32x4*)(C + off + bj * HALF + n * 16) = acc[ai][bj][m][n] * scale + r[bj][n];
                asm volatile("" ::: "memory"); }
    }
};
__device__ __forceinline__ float silu_mul(float g, float u) { const float e = __builtin_amdgcn_exp2f(g * -1.4426950408889634f); return g * __builtin_amdgcn_rcpf(1.0f + e) * u; }
struct EpiSwiGLU {
    static constexpr bool PERM = true, AFTER_DRAIN = false;
    bf16_t* O; int ldc;
    __device__ __forceinline__ void operator()(const f32x4 (&acc)[2][2][4][2], const Unit& u, int wr, int wc, int fr, int fq) const {
        const int row0 = u.pm * BM + wr * 64 + fr, col0 = u.pn * HALF + wc * 32 + 8 * fq;
#pragma unroll
        for (int ai = 0; ai < 2; ++ai)
#pragma unroll
            for (int m = 0; m < 4; ++m) { bf16_t* rowp = O + (size_t)(row0 + ai * HALF + m * 16) * ldc + col0;
                const f32x4 g0 = acc[ai][0][m][0], g1 = acc[ai][0][m][1], u0 = acc[ai][1][m][0], u1 = acc[ai][1][m][1];
                u32x4 w; w.x = cvt_pk_bf16(silu_mul(g0[0], u0[0]), silu_mul(g0[1], u0[1])); w.y = cvt_pk_bf16(silu_mul(g0[2], u0[2]), silu_mul(g0[3], u0[3]));
                w.z = cvt_pk_bf16(silu_mul(g1[0], u1[0]), silu_mul(g1[1], u1[1])); w.w = cvt_pk_bf16(silu_mul(g1[2], u1[2]), silu_mul(g1[3], u1[3]));
                *(u32x4*)rowp = w; }
    }
};
template <int LDC> struct EpiSwiGLU8 {
    static constexpr bool PERM = true, AFTER_DRAIN = false;
    unsigned char* O; float ascale, oscale;
    __device__ __forceinline__ void operator()(const f32x4 (&acc)[2][2][4][2], const Unit& u, int wr, int wc, int fr, int fq) const {
        const unsigned row0 = u.pm * BM + wr * 64 + fr, col0 = u.pn * HALF + wc * 32 + 8 * fq;
        typedef unsigned u32x2 __attribute__((ext_vector_type(2)));
#pragma unroll
        for (int ai = 0; ai < 2; ++ai)
#pragma unroll
            for (int m = 0; m < 4; ++m) { unsigned char* rowp = O + ((row0 + ai * HALF + m * 16) * (unsigned)LDC + col0);
                const f32x4 g0 = acc[ai][0][m][0] * ascale, g1 = acc[ai][0][m][1] * ascale, u0 = acc[ai][1][m][0] * ascale, u1 = acc[ai][1][m][1] * ascale;
                u32x2 w; w.x = pk4_fp8(silu_mul(g0[0], u0[0]) * oscale, silu_mul(g0[1], u0[1]) * oscale, silu_mul(g0[2], u0[2]) * oscale, silu_mul(g0[3], u0[3]) * oscale);
                w.y = pk4_fp8(silu_mul(g1[0], u1[0]) * oscale, silu_mul(g1[1], u1[1]) * oscale, silu_mul(g1[2], u1[2]) * oscale, silu_mul(g1[3], u1[3]) * oscale);
                *(u32x2*)rowp = w; }
    }
};
struct EpiSwiGLUI8 {
    static constexpr bool PERM = true, AFTER_DRAIN = false;
    bf16_t* O; int ldc; const float* sa; const float* sw;
    __device__ __forceinline__ void operator()(const f32x4 (&acc)[2][2][4][2], const Unit& u, int wr, int wc, int fr, int fq) const {
        const int row0 = u.pm * BM + wr * 64 + fr, col0 = u.pn * HALF + wc * 32 + 8 * fq; const float w = *sw;
#pragma unroll
        for (int ai = 0; ai < 2; ++ai)
#pragma unroll
            for (int m = 0; m < 4; ++m) { const int row = row0 + ai * HALF + m * 16; bf16_t* rowp = O + (size_t)row * ldc + col0; const float s = sa[row] * w;
                const v4i_t g0 = __builtin_bit_cast(v4i_t, acc[ai][0][m][0]), g1 = __builtin_bit_cast(v4i_t, acc[ai][0][m][1]), u0 = __builtin_bit_cast(v4i_t, acc[ai][1][m][0]), u1 = __builtin_bit_cast(v4i_t, acc[ai][1][m][1]);
                u32x4 o; o.x = cvt_pk_bf16(silu_mul((float)g0.x * s, (float)u0.x * s), silu_mul((float)g0.y * s, (float)u0.y * s)); o.y = cvt_pk_bf16(silu_mul((float)g0.z * s, (float)u0.z * s), silu_mul((float)g0.w * s, (float)u0.w * s));
                o.z = cvt_pk_bf16(silu_mul((float)g1.x * s, (float)u1.x * s), silu_mul((float)g1.y * s, (float)u1.y * s)); o.w = cvt_pk_bf16(silu_mul((float)g1.z * s, (float)u1.z * s), silu_mul((float)g1.w * s, (float)u1.w * s));
                *(u32x4*)rowp = o; }
    }
};
template <int LDC> struct EpiScaleBf16Tail {
    static constexpr bool PERM = true, AFTER_DRAIN = false;
    bf16_t* O; float scale; float* slab;
    __device__ __forceinline__ void operator()(const f32x4 (&acc)[2][2][4][2], const Unit& u, int wr, int wc, int fr, int fq) const {
        if (u.slot < 0) {
            const unsigned row0 = u.pm * BM + wr * 64 + fr, col0 = u.pn * BM + wc * 32 + 8 * fq;
#pragma unroll
            for (int ai = 0; ai < 2; ++ai)
#pragma unroll
                for (int m = 0; m < 4; ++m) { bf16_t* rowp = O + ((row0 + ai * HALF + m * 16) * (unsigned)LDC + col0);
#pragma unroll
                    for (int bj = 0; bj < 2; ++bj) { const f32x4 v0 = acc[ai][bj][m][0] * scale, v1 = acc[ai][bj][m][1] * scale;
                        u32x4 w; w.x = cvt_pk_bf16(v0[0], v0[1]); w.y = cvt_pk_bf16(v0[2], v0[3]); w.z = cvt_pk_bf16(v1[0], v1[1]); w.w = cvt_pk_bf16(v1[2], v1[3]);
                        *(u32x4*)(rowp + bj * HALF) = w; } }
        } else {
            float* T = slab + (unsigned)u.slot * 65536u; const unsigned row0 = wr * 64 + fr, col0 = wc * 32 + 8 * fq;
#pragma unroll
            for (int ai = 0; ai < 2; ++ai)
#pragma unroll
                for (int m = 0; m < 4; ++m) { float* rowp = T + ((row0 + ai * HALF + m * 16) * 256u + col0);
#pragma unroll
                    for (int bj = 0; bj < 2; ++bj) { *(f32x4*)(rowp + bj * HALF) = acc[ai][bj][m][0] * scale; *(f32x4*)(rowp + bj * HALF + 4) = acc[ai][bj][m][1] * scale; } }
        }
    }
};
template <int LDC> struct EpiScaleBf16 {
    static constexpr bool PERM = true, AFTER_DRAIN = false;
    bf16_t* O; float scale;
    __device__ __forceinline__ void operator()(const f32x4 (&acc)[2][2][4][2], const Unit& u, int wr, int wc, int fr, int fq) const {
        const unsigned row0 = u.pm * BM + wr * 64 + fr, col0 = u.pn * BM + wc * 32 + 8 * fq;
#pragma unroll
        for (int ai = 0; ai < 2; ++ai)
#pragma unroll
            for (int m = 0; m < 4; ++m) { bf16_t* rowp = O + ((row0 + ai * HALF + m * 16) * (unsigned)LDC + col0);
#pragma unroll
                for (int bj = 0; bj < 2; ++bj) { const f32x4 v0 = acc[ai][bj][m][0] * scale, v1 = acc[ai][bj][m][1] * scale;
                    u32x4 w; w.x = cvt_pk_bf16(v0[0], v0[1]); w.y = cvt_pk_bf16(v0[2], v0[3]); w.z = cvt_pk_bf16(v1[0], v1[1]); w.w = cvt_pk_bf16(v1[2], v1[3]);
                    *(u32x4*)(rowp + bj * HALF) = w; } }
    }
};
template <int LDC> struct EpiScaleF32 {
    static constexpr bool PERM = false, AFTER_DRAIN = false;
    float* C; float scale;
    __device__ __forceinline__ void operator()(const f32x4 (&acc)[2][2][4][2], const Unit& u, int wr, int wc, int fr, int fq) const {
        const unsigned row0 = u.pm * BM + wr * 64 + fr, col0 = u.pn * BM + wc * 32 + 4 * fq;
#pragma unroll
        for (int ai = 0; ai < 2; ++ai)
#pragma unroll
            for (int m = 0; m < 4; ++m) { float* rowp = C + ((row0 + ai * HALF + m * 16) * (unsigned)LDC + col0);
#pragma unroll
                for (int bj = 0; bj < 2; ++bj)
#pragma unroll
                    for (int n = 0; n < 2; ++n) *(f32x4*)(rowp + bj * HALF + n * 16) = acc[ai][bj][m][n] * scale; }
    }
};

template <class Epi, class Sched, bool ALIGN_EPI = false, bool SP2 = false, bool F8 = false, bool I8 = false>
__device__ __forceinline__ void gemm_phase(PG8_LAS unsigned char* lds, const Gemm g, const Sched& S, const Epi& E, const int wid) {
    const int lane = lane_id_fresh(), tid = wid * 64 + lane, wr = wid >> 2, wc = wid & 3, fr = lane & 15, fq = lane >> 4;
    const int K = g.K, nt = K / BK;
    unsigned voffA[2], voffB[2];
#pragma unroll
    for (int i = 0; i < 2; ++i) { int R, C; stage_rc(tid * 16 + i * 8192, R, C); const int Rb = Epi::PERM ? ((R & ~31) + perm32(R & 31)) : R;
        voffA[i] = (unsigned)(R * K + C) * 2u; voffB[i] = (unsigned)(Rb * K + C) * 2u; }
    const unsigned kstep = (unsigned)(BK * 2);
    const unsigned hstep = (unsigned)HALF * K * 2;
    const unsigned tstep = 2 * hstep;
    const __amdgpu_buffer_rsrc_t rsA = __builtin_amdgcn_make_buffer_rsrc((void*)g.A, 0, 0xffffffff, 0x00020000), rsB = __builtin_amdgcn_make_buffer_rsrc((void*)g.Bt, 0, 0xffffffff, 0x00020000);
    const unsigned ldsw = (unsigned)wid * 1024u;
    const int aoff = lds_byte(wr * 64 + fr, fq * 8), boff = lds_byte(wc * 32 + fr, fq * 8);
#define PG8_SA(b, h) (((b) * 2 + (h)) * HTB)
#define PG8_SB(b, h) ((4 + (b) * 2 + (h)) * HTB)
#define PG8_STAGE(rs, bufoff, gbase, voff) do { _Pragma("unroll") for (int _i = 0; _i < 2; ++_i) \
        __builtin_amdgcn_raw_ptr_buffer_load_lds(rs, (PG8_LAS unsigned*)(lds + (bufoff) + ldsw + _i * 8192), 16, (int)(voff)[_i], (int)(gbase), 0, 0); } while (0)
#define PG8_LDA(dst, b, h) do { if constexpr (F8) { _Pragma("unroll") for (int m = 0; m < 4; ++m) { dst##8[m].lo = *(const PG8_LAS v4i_t*)(lds + PG8_SA(b, h) + aoff + m * 2048); dst##8[m].hi = *(const PG8_LAS v4i_t*)(lds + PG8_SA(b, h) + aoff + m * 2048 + 1024); } } \
    else { _Pragma("unroll") for (int m = 0; m < 4; ++m) _Pragma("unroll") for (int k = 0; k < 2; ++k) dst[m][k] = *(const PG8_LAS bf16x8*)(lds + PG8_SA(b, h) + aoff + m * 2048 + k * 1024); } } while (0)
#define PG8_LDB(dst, b, h) do { if constexpr (F8) { _Pragma("unroll") for (int n = 0; n < 2; ++n) { dst##8[n].lo = *(const PG8_LAS v4i_t*)(lds + PG8_SB(b, h) + boff + n * 2048); dst##8[n].hi = *(const PG8_LAS v4i_t*)(lds + PG8_SB(b, h) + boff + n * 2048 + 1024); } } \
    else { _Pragma("unroll") for (int n = 0; n < 2; ++n) _Pragma("unroll") for (int k = 0; k < 2; ++k) dst[n][k] = *(const PG8_LAS bf16x8*)(lds + PG8_SB(b, h) + boff + n * 2048 + k * 1024); } } while (0)
#define PG8_MMA(ai, bj, At, Bt) do { __builtin_amdgcn_s_setprio(1); if constexpr (F8) { _Pragma("unroll") for (int m = 0; m < 4; ++m) _Pragma("unroll") for (int n = 0; n < 2; ++n) \
        { if (n == 0) acc8[ai][bj][m].lo = __builtin_amdgcn_mfma_scale_f32_16x16x128_f8f6f4(Bt##8[0], At##8[m], acc8[ai][bj][m].lo, 0, 0, 0, f8scl, 0, f8scl); else acc8[ai][bj][m].hi = __builtin_amdgcn_mfma_scale_f32_16x16x128_f8f6f4(Bt##8[1], At##8[m], acc8[ai][bj][m].hi, 0, 0, 0, f8scl, 0, f8scl); } } \
    else if constexpr (I8) { _Pragma("unroll") for (int m = 0; m < 4; ++m) _Pragma("unroll") for (int n = 0; n < 2; ++n) _Pragma("unroll") for (int k = 0; k < 2; ++k) \
        acc[ai][bj][m][n] = __builtin_bit_cast(f32x4, __builtin_amdgcn_mfma_i32_16x16x64_i8(__builtin_bit_cast(v4i_t, Bt[n][k]), __builtin_bit_cast(v4i_t, At[m][k]), __builtin_bit_cast(v4i_t, acc[ai][bj][m][n]), 0, 0, 0)); } \
    else { _Pragma("unroll") for (int m = 0; m < 4; ++m) _Pragma("unroll") for (int n = 0; n < 2; ++n) _Pragma("unroll") for (int k = 0; k < 2; ++k) \
        acc[ai][bj][m][n] = __builtin_amdgcn_mfma_f32_16x16x32_bf16(Bt[n][k], At[m][k], acc[ai][bj][m][n], 0, 0, 0); } __builtin_amdgcn_s_setprio(0); } while (0)
#define PG8_WAIT_V(n) asm volatile("s_waitcnt vmcnt(" #n ")" ::: "memory")
#define PG8_WAIT_L(n) asm volatile("s_waitcnt lgkmcnt(" #n ")" ::: "memory")
#define PG8_BAR __builtin_amdgcn_s_barrier()
#define PG8_SCHED __builtin_amdgcn_sched_barrier(0)
#define PG8_ZERO8() do { if constexpr (F8) { _Pragma("unroll") for (int a = 0; a < 2; ++a) _Pragma("unroll") for (int b = 0; b < 2; ++b) _Pragma("unroll") for (int m = 0; m < 4; ++m) acc8[a][b][m] = (f32x8_t){0.f, 0.f, 0.f, 0.f, 0.f, 0.f, 0.f, 0.f}; } } while (0)
#define PG8_UNPACK8() do { if constexpr (F8) { _Pragma("unroll") for (int a = 0; a < 2; ++a) _Pragma("unroll") for (int b = 0; b < 2; ++b) _Pragma("unroll") for (int m = 0; m < 4; ++m) { acc[a][b][m][0] = acc8[a][b][m].lo; acc[a][b][m][1] = acc8[a][b][m].hi; } } } while (0)
    Unit cur, nxt; int ui = 0;
    if (!S.next(0, cur)) return;
    f32x4 acc[2][2][4][2];
    bf16x8 At[4][2], B0[2][2], B1[2][2]; v8i_t At8[4], B08[2], B18[2]; typedef float f32x8_t __attribute__((ext_vector_type(8))); f32x8_t acc8[2][2][4];
#pragma unroll
    for (int a = 0; a < 2; ++a)
#pragma unroll
        for (int b = 0; b < 2; ++b)
#pragma unroll
            for (int m = 0; m < 4; ++m)
#pragma unroll
                for (int n = 0; n < 2; ++n) acc[a][b][m][n] = (f32x4){0.f, 0.f, 0.f, 0.f};
    PG8_ZERO8();
    const int f8scl = 0x7f7f7f7f;
    unsigned cA = (unsigned)cur.pm * tstep, cB = (unsigned)cur.boff + (unsigned)cur.pn * tstep;
    if constexpr (Sched::SPLITK) { cA += Sched::koff(cur); cB += Sched::koff(cur); }
    S.a_ready(cur);
    if constexpr (SP2) {
        PG8_STAGE(rsB, PG8_SB(0, 0), cB, voffB); PG8_STAGE(rsB, PG8_SB(0, 1), cB + hstep, voffB); PG8_STAGE(rsA, PG8_SA(0, 0), cA, voffA); PG8_STAGE(rsA, PG8_SA(0, 1), cA + hstep, voffA);
        if (wr == 1) PG8_BAR;
        PG8_WAIT_V(2); PG8_BAR;
        PG8_STAGE(rsB, PG8_SB(1, 0), cB + kstep, voffB); PG8_STAGE(rsA, PG8_SA(1, 0), cA + kstep, voffA); PG8_STAGE(rsB, PG8_SB(1, 1), cB + hstep + kstep, voffB);
        PG8_WAIT_V(6); PG8_BAR;
    } else {
        PG8_STAGE(rsB, PG8_SB(0, 0), cB, voffB); PG8_STAGE(rsA, PG8_SA(0, 0), cA, voffA); PG8_STAGE(rsB, PG8_SB(0, 1), cB + hstep, voffB); PG8_STAGE(rsA, PG8_SA(0, 1), cA + hstep, voffA);
        if (wr == 1) PG8_BAR;
        PG8_WAIT_V(4); PG8_BAR;
        PG8_STAGE(rsB, PG8_SB(1, 0), cB + kstep, voffB); PG8_STAGE(rsA, PG8_SA(1, 0), cA + kstep, voffA); PG8_STAGE(rsB, PG8_SB(1, 1), cB + hstep + kstep, voffB);
        PG8_WAIT_V(6); PG8_BAR;
    }
    for (;;) {
        const bool has_next = S.next(ui + 1, nxt);
        unsigned nA = has_next ? (unsigned)nxt.pm * tstep : cA, nB = has_next ? (unsigned)nxt.boff + (unsigned)nxt.pn * tstep : cB;
        if constexpr (Sched::SPLITK) { if (has_next) { nA += Sched::koff(nxt); nB += Sched::koff(nxt); } }
        int ntc = nt; if constexpr (Sched::SPLITK) ntc = Sched::ntile(cur);
        for (int t = 0; t < ntc; t += 2) {
            const bool last = (t == ntc - 2);
            const unsigned a1 = cA + (unsigned)(t + 1) * kstep;
            const unsigned a2 = last ? nA : cA + (unsigned)(t + 2) * kstep, b2 = last ? nB : cB + (unsigned)(t + 2) * kstep;
            const unsigned a3 = a2 + kstep, b3 = b2 + kstep;
            if (last && has_next) S.a_ready(nxt);
            if constexpr (SP2) {
            PG8_LDB(B0, 0, 0); PG8_LDB(B1, 0, 1); PG8_SCHED; PG8_LDA(At, 0, 0); PG8_STAGE(rsA, PG8_SA(1, 1), a1 + hstep, voffA);
            PG8_WAIT_V(8); PG8_WAIT_L(0); PG8_BAR; PG8_MMA(0, 0, At, B0); PG8_MMA(0, 1, At, B1); PG8_BAR; PG8_SCHED;
            PG8_LDA(At, 0, 1); PG8_STAGE(rsB, PG8_SB(0, 0), b2, voffB); PG8_STAGE(rsB, PG8_SB(0, 1), b2 + hstep, voffB); PG8_STAGE(rsA, PG8_SA(0, 0), a2, voffA);
            PG8_WAIT_V(8); PG8_WAIT_L(0); PG8_BAR; PG8_MMA(1, 0, At, B0); PG8_MMA(1, 1, At, B1); PG8_BAR; PG8_SCHED;
            PG8_LDB(B0, 1, 0); PG8_LDB(B1, 1, 1); PG8_SCHED; PG8_LDA(At, 1, 0); PG8_STAGE(rsA, PG8_SA(0, 1), a2 + hstep, voffA);
            PG8_WAIT_V(8); PG8_WAIT_L(0); PG8_BAR; PG8_MMA(0, 0, At, B0); PG8_MMA(0, 1, At, B1); PG8_BAR; PG8_SCHED;
            PG8_LDA(At, 1, 1); PG8_STAGE(rsB, PG8_SB(1, 0), b3, voffB); PG8_STAGE(rsB, PG8_SB(1, 1), b3 + hstep, voffB); PG8_STAGE(rsA, PG8_SA(1, 0), a3, voffA);
            PG8_WAIT_V(8); PG8_WAIT_L(0); PG8_BAR; PG8_MMA(1, 0, At, B0); PG8_MMA(1, 1, At, B1); PG8_BAR; PG8_SCHED;
            } else {
            PG8_LDB(B0, 0, 0); PG8_SCHED; PG8_LDA(At, 0, 0); PG8_STAGE(rsA, PG8_SA(1, 1), a1 + hstep, voffA);
            PG8_WAIT_L(8); PG8_BAR; PG8_WAIT_L(0); PG8_MMA(0, 0, At, B0); PG8_BAR; PG8_SCHED;
            PG8_LDB(B1, 0, 1); PG8_STAGE(rsB, PG8_SB(0, 0), b2, voffB);
            PG8_BAR; PG8_WAIT_L(0); PG8_MMA(0, 1, At, B1); PG8_BAR;
            PG8_LDA(At, 0, 1); PG8_STAGE(rsA, PG8_SA(0, 0), a2, voffA);
            PG8_BAR; PG8_WAIT_L(0); PG8_MMA(1, 0, At, B0); PG8_BAR; PG8_SCHED;
            PG8_STAGE(rsB, PG8_SB(0, 1), b2 + hstep, voffB);
            PG8_WAIT_V(6); PG8_BAR; PG8_MMA(1, 1, At, B1); PG8_BAR;
            PG8_LDB(B0, 1, 0); PG8_SCHED; PG8_LDA(At, 1, 0); PG8_STAGE(rsA, PG8_SA(0, 1), a2 + hstep, voffA);
            PG8_WAIT_L(8); PG8_BAR; PG8_WAIT_L(0); PG8_MMA(0, 0, At, B0); PG8_BAR; PG8_SCHED;
            PG8_LDB(B1, 1, 1); PG8_STAGE(rsB, PG8_SB(1, 0), b3, voffB);
            PG8_BAR; PG8_WAIT_L(0); PG8_MMA(0, 1, At, B1); PG8_BAR;
            PG8_LDA(At, 1, 1); PG8_STAGE(rsA, PG8_SA(1, 0), a3, voffA);
            PG8_BAR; PG8_WAIT_L(0); PG8_MMA(1, 0, At, B0); PG8_BAR; PG8_SCHED;
            PG8_STAGE(rsB, PG8_SB(1, 1), b3 + hstep, voffB);
            PG8_WAIT_V(6); PG8_BAR; PG8_MMA(1, 1, At, B1); PG8_BAR;
            }
        }
        if constexpr (ALIGN_EPI) { if (wr == 0) PG8_BAR; }
        PG8_UNPACK8();
        if constexpr (!Epi::AFTER_DRAIN) { const int le = lane_id_fresh(); E(acc, cur, wr, wc, le & 15, le >> 4); S.done(cur); }
        if (!has_next) break;
#pragma unroll
        for (int a = 0; a < 2; ++a)
#pragma unroll
            for (int b = 0; b < 2; ++b)
#pragma unroll
                for (int m = 0; m < 4; ++m)
#pragma unroll
                    for (int n = 0; n < 2; ++n) acc[a][b][m][n] = (f32x4){0.f, 0.f, 0.f, 0.f};
        PG8_ZERO8();
        cur = nxt; cA = nA; cB = nB; ++ui;
        if constexpr (ALIGN_EPI) { if (wr == 1) PG8_BAR; }
    }
    PG8_WAIT_V(0);
    if constexpr (!ALIGN_EPI) { if (wr == 0) PG8_BAR; }
    PG8_BAR;
    if constexpr (Epi::AFTER_DRAIN) { E.fused(acc, cur, wr, wc, fr, fq, lds, wid, lane); S.done(cur); }
#undef PG8_SA
#undef PG8_SB
#undef PG8_STAGE
#undef PG8_LDA
#undef PG8_LDB
#undef PG8_MMA
#undef PG8_WAIT_V
#undef PG8_WAIT_L
#undef PG8_BAR
#undef PG8_SCHED
#undef PG8_ZERO8
#undef PG8_UNPACK8
}
}

constexpr int BATCH = 2, SEQ = 8192, DM = 2048, MTOK = BATCH * SEQ, NH = 16, HD = 128, FFD = 5632, NE = 8, FFE = 7168, NBLK = SEQ / 256;
constexpr float RMS_EPS = 1e-6f;
constexpr int NWAVES = 8;
constexpr float F8_WSCALE = 64.0f, F8_ASCALE = 16.0f, F8_HSCALE = 8.0f;
constexpr int NPHASE = 20;
#ifndef MK_N_LAUNCHES
#define MK_N_LAUNCHES 1
#endif
constexpr int N_LAUNCHES = MK_N_LAUNCHES;
static_assert(N_LAUNCHES == 1 || N_LAUNCHES == NPHASE, "MK_N_LAUNCHES is 1 or NPHASE");

constexpr size_t MiB = 1u << 20, KiB = 1u << 10;
constexpr size_t WS_CTL = 0, CTL_ZERO_BYTES = 768 * KiB;
constexpr size_t WS_KMEAN = 256 * KiB;
constexpr size_t WS_KNORM = 2 * MiB + 256 * KiB;
constexpr size_t WS_SY = 2 * MiB + 320 * KiB;
constexpr size_t WS_WRG = 1 * MiB + 512 * KiB;
constexpr size_t WS_TOKE = 1 * MiB + 640 * KiB;
constexpr size_t WS_TOKG = 1 * MiB + 768 * KiB;
constexpr size_t WS_TOKR = 1 * MiB + 896 * KiB;
constexpr size_t WS_TOKP = 2 * MiB;
constexpr size_t WS_CNT = 2 * MiB + 128 * KiB;
constexpr size_t WS_META = 2 * MiB + 192 * KiB;
constexpr size_t WS_WQK0 = 4 * MiB, WS_WV0 = 20 * MiB, WS_WO0 = 28 * MiB, WS_W13D = 36 * MiB, WS_W2D = 80 * MiB;
constexpr size_t WS_WQK1 = 102 * MiB, WS_WV1 = 118 * MiB, WS_WO1 = 126 * MiB, WS_W13M = 134 * MiB, WS_W2M = 582 * MiB;
constexpr size_t WS_H = 806 * MiB;
constexpr size_t WS_Y = 934 * MiB;
constexpr size_t WS_QK = 998 * MiB, WS_VT = 1126 * MiB, WS_AO = 1190 * MiB;
constexpr size_t WS_XS = 998 * MiB, WS_YS = 998 * MiB;
constexpr size_t WS_SLAB = 1192 * MiB;
constexpr size_t WS_LIST = 1270 * MiB;
constexpr size_t WS_PB = 1286 * MiB;
constexpr size_t WS_HID = 1270 * MiB;
constexpr size_t WS_END = 1746 * MiB;
constexpr int MOE_ROWS = 34816;
constexpr int CW_TMO = 0, CW_CODE = 1, CW_BAR = 4096, CW_AMAXW = 16;

constexpr int LDS_BYTES = 147456;
constexpr int MISC_OFF = LDS_BYTES - 256;
constexpr int RING_BYTES = 131072;

#define GAS __attribute__((address_space(1)))
#define LAS __attribute__((address_space(3)))
typedef unsigned short bf16;
typedef unsigned v4u __attribute__((ext_vector_type(4)));
typedef float f32x4 __attribute__((ext_vector_type(4)));
typedef short bf16x8 __attribute__((ext_vector_type(8)));
typedef GAS unsigned gu32;
typedef GAS unsigned long long gu64;
#define RLX_AGENT __ATOMIC_RELAXED, __HIP_MEMORY_SCOPE_AGENT
#define LDS_WAIT() asm volatile("s_waitcnt lgkmcnt(0)" ::: "memory")
#define VM_WAIT() asm volatile("s_waitcnt vmcnt(0)" ::: "memory")
__device__ __forceinline__ unsigned long long rt() { return __builtin_amdgcn_s_memrealtime(); }
__device__ __forceinline__ unsigned f2bf(float f) { unsigned u = __builtin_bit_cast(unsigned, f); return (u + 0x7fffu + ((u >> 16) & 1u)) >> 16; }
__device__ __forceinline__ unsigned pk2(float lo, float hi) { return f2bf(lo) | (f2bf(hi) << 16); }

#define XB_TMO      128
#define XB_XCNT(j)  (256  + 64 * (j))
#define XB_XSUB(j)  (1280 + 64 * (j))
#define XB_XGEN(j)  (2304 + 64 * (j))
#define XB_TOP      3328
#define XB_TOPGEN   3392
#define XCD_BAR_WORDS 3456
#define XB_SPIN_CAP (1u << 18)

__device__ __forceinline__ unsigned xb_ld(unsigned* p)              { return __hip_atomic_load(p, __ATOMIC_RELAXED, __HIP_MEMORY_SCOPE_AGENT); }
__device__ __forceinline__ unsigned xb_add(unsigned* p, unsigned v) { return __hip_atomic_fetch_add(p, v, __ATOMIC_RELAXED, __HIP_MEMORY_SCOPE_AGENT); }
__device__ __forceinline__ unsigned xb_xcc_id() { return (unsigned)__builtin_amdgcn_s_getreg((3 << 11) | 20) & 0xFu; }
#define XB_SPIN(cond, bar) do { unsigned _sp = 0; while (cond) { __builtin_amdgcn_s_sleep(1); \
    if ((++_sp & 255u) == 0u) { if (xb_ld(&(bar)[XB_TMO])) break; if (_sp > XB_SPIN_CAP) { atomicAdd(&(bar)[XB_TMO], 1u); break; } } } } while (0)

struct XcdBarrier {
    unsigned* bar; unsigned x;
    int wave;
    volatile LAS unsigned* st;
};

__device__ __forceinline__ XcdBarrier xcd_barrier_post(unsigned* bar, volatile LAS unsigned* st, int wave) {
    XcdBarrier b; b.bar = bar; b.x = xb_xcc_id(); b.st = st; b.wave = wave;
    if (wave == 0 && lane_id() == 0) (void)xb_add(&bar[XB_XCNT(b.x)], 1u);
    return b;
}
__device__ __forceinline__ void xcd_barrier_complete(unsigned* bar, unsigned x, unsigned& nloc, unsigned& nx) {
    const unsigned G = gridDim.x * gridDim.y * gridDim.z;
    unsigned sum, cnt, mine, sp = 0u;
    for (;;) {
        sum = 0u; cnt = 0u; mine = 0u;
#pragma unroll
        for (unsigned j = 0; j < 16; ++j) { const unsigned c = xb_ld(&bar[XB_XCNT(j)]); sum += c; cnt += (c > 0u) ? 1u : 0u; mine = (j == x) ? c : mine; }
        if (sum == G) break;
        __builtin_amdgcn_s_sleep(1);
        if ((++sp & 255u) == 0u) { if (xb_ld(&bar[XB_TMO])) break; if (sp > XB_SPIN_CAP) { atomicAdd(&bar[XB_TMO], 1u); break; } }
    }
    nloc = mine > 0u ? mine : 1u; nx = cnt > 0u ? cnt : 1u;
}

__device__ __forceinline__ void xcd_barrier(const XcdBarrier& b) {
    asm volatile("s_waitcnt vmcnt(0)" ::: "memory");
    __syncthreads();
    if (b.wave == 0 && lane_id() == 0) {
        unsigned* bar = b.bar;
        __builtin_amdgcn_s_waitcnt(0);
        unsigned nloc = b.st[0], nx = b.st[1];
        if (nloc == 0u) { xcd_barrier_complete(bar, b.x, nloc, nx); b.st[0] = nloc; b.st[1] = nx; }
        const unsigned old = xb_add(&bar[XB_XSUB(b.x)], 1u);
        const unsigned gen = old / nloc;
        if (old + 1u == (gen + 1u) * nloc) {
            __builtin_amdgcn_fence(__ATOMIC_RELEASE, "agent");
            asm volatile("s_waitcnt vmcnt(0)" ::: "memory");
            const unsigned og = xb_add(&bar[XB_TOP], 1u);
            const unsigned tg = og / nx;
            if (og + 1u == (tg + 1u) * nx) xb_add(&bar[XB_TOPGEN], 1u);
            else XB_SPIN(xb_ld(&bar[XB_TOPGEN]) == tg, bar);
            __builtin_amdgcn_fence(__ATOMIC_ACQUIRE, "agent");
            xb_add(&bar[XB_XGEN(b.x)], 1u);
            asm volatile("s_waitcnt vmcnt(0)" ::: "memory");
        } else {
            XB_SPIN(xb_ld(&bar[XB_XGEN(b.x)]) == gen, bar);
            __builtin_amdgcn_fence(__ATOMIC_ACQUIRE, "agent");
            asm volatile("s_waitcnt vmcnt(0)" ::: "memory");
        }
    }
    __syncthreads();
}

typedef float f32x16 __attribute__((ext_vector_type(16)));
typedef float f32x2v __attribute__((ext_vector_type(2)));
typedef __bf16 bf16x2v __attribute__((ext_vector_type(2)));
typedef short s16x4 __attribute__((ext_vector_type(4)));
struct Frame {
    LAS unsigned char* lds;
    volatile LAS unsigned* MISC;
    gu32* ctl;
    int wave;
    int vcu, G;
    unsigned char* ws;
};
struct Args { const float* in[17]; float* out; unsigned char* ws; int ph_lo, ph_hi; };
__device__ __forceinline__ float wave_sum(float v) {
#pragma unroll
    for (int o = 1; o < 64; o <<= 1) v += __shfl_xor(v, o);
    return v;
}
__device__ __forceinline__ float wave_sum_l(float v, int lane) {
#pragma unroll
    for (int o = 1; o < 64; o <<= 1) v += __builtin_bit_cast(float, __builtin_amdgcn_ds_bpermute((lane ^ o) << 2, __builtin_bit_cast(int, v)));
    return v;
}
__device__ __forceinline__ unsigned cvtpk(float lo, float hi) { f32x2v v = {lo, hi}; bf16x2v b = __builtin_convertvector(v, bf16x2v); return __builtin_bit_cast(unsigned, b); }
__device__ __forceinline__ float bf2f(unsigned short b) { return __builtin_bit_cast(float, (unsigned)b << 16); }
__device__ __forceinline__ float swap_lo(float x, float& hi_out) { const unsigned xu = __float_as_uint(x); auto rr = __builtin_amdgcn_permlane32_swap(xu, xu, false, false); const unsigned r0 = rr[0], r1 = rr[1]; hi_out = __uint_as_float(r1); return __uint_as_float(r0); }

constexpr int CV_QK0 = 32 * 128, CV_O = 32 * 64, CV_D13 = 32 * 176, CV_D2 = 88 * 64, CV_M13 = 32 * 224, CV_M2 = 112 * 64;
constexpr int CV_EARLY = CV_QK0 + CV_O;
constexpr int CV_LATE = CV_O + 2 * CV_D13 + CV_D2 + 4 * CV_O + 8 * (2 * CV_M13 + CV_M2);
constexpr int CV_NONMOE = CV_LATE - 8 * (2 * CV_M13 + CV_M2);
constexpr int CV_SCR_OFF = 69632, CV_SCR_BYTES = 8192;
constexpr int CV_SPLIT_PER_WAVE = 66;
constexpr int CV_NONE = 1 << 28;
struct CvItem { __amdgpu_buffer_rsrc_t rs; int soff, ld; bf16* WT; int dK; const float* g; int f8, k0, drow0; float qs; const unsigned* amax; int glds; };
__device__ __forceinline__ void cv_decode(const Args& A, unsigned char* ws, int r, CvItem& I, const bool live = true) {
    r = __builtin_amdgcn_readfirstlane(r);
    I.glds = 0;
    bool hit = false; int wi = 0, wo = 0, ld = 0, K = 0, gi = -1, go = 0, mode = 0, sel = 0, roff = 0, f8 = 0, kb = 0, nn = 0; size_t dst = 0, woff = 0;
    if (r >= CV_EARLY + CV_NONMOE) {
        int q = r - (CV_EARLY + CV_NONMOE); hit = true; f8 = 1; I.glds = (q < 16 * CV_M13) ? 1 : 0;
        if (q < 16 * CV_M13) { sel = (q >= 8 * CV_M13) ? 1 : 0; q -= sel * 8 * CV_M13; const int e = q / CV_M13; q -= e * CV_M13; wi = 13 + sel; woff = (size_t)e * DM * FFE; ld = FFE; K = DM; dst = WS_W13M + (size_t)e * 2 * FFE * DM; gi = 2; go = DM; mode = 1; kb = q / (FFE / 32); nn = q % (FFE / 32); }
        else { q -= 16 * CV_M13; const int e = q / CV_M2; q -= e * CV_M2; wi = 15; woff = (size_t)e * FFE * DM; ld = DM; K = FFE; dst = WS_W2M + (size_t)e * DM * FFE; kb = q / (DM / 32); nn = q % (DM / 32); }
    }
#define JOB(cnt, wi_, wo_, ld_, K_, N_, dst_, gi_, go_, mode_, sel_, roff_) if (!hit) { if (r < (cnt)) { wi = (wi_); wo = (wo_); ld = (ld_); K = (K_); dst = (dst_); gi = (gi_); go = (go_); mode = (mode_); sel = (sel_); roff = (roff_); kb = r / ((N_) / 32); nn = r % ((N_) / 32); hit = true; } else r -= (cnt); }
    JOB(CV_QK0, 3, 0, 6144, DM, 4096, WS_WQK0, 1, 0, 0, 0, 0)
    JOB(CV_O, 3, 4096, 6144, DM, 2048, WS_WV0, 1, 0, 0, 0, 0)
    JOB(CV_O, 4, 0, 2048, DM, 2048, WS_WO0, -1, 0, 0, 0, 0)
    JOB(CV_D13, 9, 0, FFD, DM, FFD, WS_W13D, -1, 0, 1, 0, 0) if (hit && wi == 9) f8 = 2;
    JOB(CV_D13, 10, 0, FFD, DM, FFD, WS_W13D, -1, 0, 1, 1, 0) if (hit && wi == 10) f8 = 2;
    JOB(CV_D2, 11, 0, DM, FFD, DM, WS_W2D, -1, 0, 0, 0, 0)
    JOB(CV_O, 7, 0, 2048, DM, 2048, WS_WQK1, 1, DM, 0, 0, 0)
    JOB(CV_O, 6, 0, 4096, DM, 2048, WS_WQK1, 5, 0, 0, 0, 2048)
    JOB(CV_O, 6, 2048, 4096, DM, 2048, WS_WV1, 5, 0, 0, 0, 0)
    JOB(CV_O, 8, 0, 2048, DM, 2048, WS_WO1, -1, 0, 0, 0, 0)
    if (!hit) { if (r < 8 * CV_M13) { const int e = r / CV_M13; r -= e * CV_M13; wi = 13; woff = (size_t)e * DM * FFE; ld = FFE; K = DM; dst = WS_W13M + (size_t)e * 2 * FFE * DM; gi = 2; go = DM; mode = 1; sel = 0; f8 = 1; kb = r / (FFE / 32); nn = r % (FFE / 32); hit = true; } else r -= 8 * CV_M13; }
    if (!hit) { if (r < 8 * CV_M13) { const int e = r / CV_M13; r -= e * CV_M13; wi = 14; woff = (size_t)e * DM * FFE; ld = FFE; K = DM; dst = WS_W13M + (size_t)e * 2 * FFE * DM; gi = 2; go = DM; mode = 1; sel = 1; f8 = 1; kb = r / (FFE / 32); nn = r % (FFE / 32); hit = true; } else r -= 8 * CV_M13; }
    if (!hit) { const int e = r / CV_M2; r -= e * CV_M2; wi = 15; woff = (size_t)e * FFE * DM; ld = DM; K = FFE; dst = WS_W2M + (size_t)e * DM * FFE; f8 = 1; kb = r / (DM / 32); nn = r % (DM / 32); hit = true; }
#undef JOB
    const int k0 = kb * 64, n0 = nn * 32;
    I.rs = __builtin_amdgcn_make_buffer_rsrc((void*)(A.in[wi] + woff + wo), 0, __builtin_amdgcn_readfirstlane(live ? -1 : 0), 0x00020000); I.soff = (k0 * ld + n0) * 4; I.ld = ld;
    I.WT = (bf16*)(ws + dst); I.dK = K; I.g = (gi >= 0) ? A.in[gi] + go : nullptr; I.f8 = f8; I.k0 = k0;
    I.qs = (f8 == 1) ? F8_WSCALE : 1.0f; I.amax = (const unsigned*)(ws + WS_CTL) + CW_AMAXW;
    I.drow0 = mode ? (n0 / 128) * 256 + sel * 128 + (n0 % 128) : roff + n0;
}
__device__ __forceinline__ void cv_issue(const CvItem& I, LAS unsigned char* scr, int lane) {
    int lv = lane; asm volatile("" : "+v"(lv));
    const int rowoff = (lv >> 3) * I.ld * 4, p = lv & 7;
#pragma unroll
    for (int q = 0; q < 8; ++q) __builtin_amdgcn_raw_ptr_buffer_load_lds(I.rs, (LAS unsigned*)(scr + q * 1024), 16, rowoff + ((p ^ q) << 4), I.soff + q * 8 * I.ld * 4, 0, 2);
}
__device__ __forceinline__ void cv_gload(const CvItem& I, int lane, f32x4& ga, f32x4& gb, const LAS float* g2 = nullptr, const bool use_g2 = false) {
    const int c = lane & 7; ga = (f32x4){1.f, 1.f, 1.f, 1.f}; gb = ga;
    if (use_g2 && I.glds) { ga = *(const LAS f32x4*)(g2 + I.k0 + 8 * c); gb = *(const LAS f32x4*)(g2 + I.k0 + 8 * c + 4); }
    else if (I.g) { ga = *(const GAS f32x4*)(I.g + I.k0 + 8 * c); gb = *(const GAS f32x4*)(I.g + I.k0 + 8 * c + 4); }
    float qs = I.qs; if (I.f8 == 2) qs = 127.0f / fmaxf(__uint_as_float(__hip_atomic_load(I.amax, __ATOMIC_RELAXED, __HIP_MEMORY_SCOPE_AGENT)), 1e-30f);
    ga = ga * qs; gb = gb * qs;
}
template <int WAITN> __device__ __forceinline__ void cv_finish_g(const CvItem& I, const LAS unsigned char* scrb, int lane, f32x4 ga, f32x4 gb) {
    if (WAITN == 8) asm volatile("s_waitcnt vmcnt(8)" ::: "memory"); else asm volatile("s_waitcnt vmcnt(0)" ::: "memory");
    const LAS float* scr = (const LAS float*)scrb;
    const int c = lane & 7, nn = lane >> 3;
    int lbase = c * 256 + 8 * (c >> 1) + 4 * ((nn >> 2) ^ (c & 1)) + (nn & 3); asm volatile("" : "+v"(lbase));
#pragma unroll
    for (int jj = 0; jj < 4; ++jj) { const int n = nn + 8 * jj; float x[8]; const LAS float* bp = scr + (lbase ^ (8 * jj));
#pragma unroll
        for (int i = 0; i < 8; ++i) x[i] = bp[32 * i];
        if (I.f8 == 2) { typedef unsigned v2u __attribute__((ext_vector_type(2)));
            const int q0 = (int)rintf(x[0] * ga.x), q1 = (int)rintf(x[1] * ga.y), q2 = (int)rintf(x[2] * ga.z), q3 = (int)rintf(x[3] * ga.w), q4 = (int)rintf(x[4] * gb.x), q5 = (int)rintf(x[5] * gb.y), q6 = (int)rintf(x[6] * gb.z), q7 = (int)rintf(x[7] * gb.w);
            v2u o; o.x = (unsigned)(q0 & 0xff) | ((unsigned)(q1 & 0xff) << 8) | ((unsigned)(q2 & 0xff) << 16) | ((unsigned)q3 << 24); o.y = (unsigned)(q4 & 0xff) | ((unsigned)(q5 & 0xff) << 8) | ((unsigned)(q6 & 0xff) << 16) | ((unsigned)q7 << 24);
            __builtin_nontemporal_store(o, (GAS v2u*)((unsigned char*)I.WT + (size_t)(I.drow0 + n) * I.dK + I.k0 + 8 * c)); }
        else if (I.f8) { typedef unsigned v2u __attribute__((ext_vector_type(2)));
            v2u o; o.x = pg8::pk4_fp8(x[0] * ga.x, x[1] * ga.y, x[2] * ga.z, x[3] * ga.w); o.y = pg8::pk4_fp8(x[4] * gb.x, x[5] * gb.y, x[6] * gb.z, x[7] * gb.w);
            __builtin_nontemporal_store(o, (GAS v2u*)((unsigned char*)I.WT + (size_t)(I.drow0 + n) * I.dK + I.k0 + 8 * c)); }
        else { v4u o; o.x = pk2(x[0] * ga.x, x[1] * ga.y); o.y = pk2(x[2] * ga.z, x[3] * ga.w); o.z = pk2(x[4] * gb.x, x[5] * gb.y); o.w = pk2(x[6] * gb.z, x[7] * gb.w);
            __builtin_nontemporal_store(o, (GAS v4u*)(I.WT + (size_t)(I.drow0 + n) * I.dK + I.k0 + 8 * c)); } }
    LDS_WAIT(); asm volatile("" ::: "memory");
}
__device__ __forceinline__ void cv_finish(const CvItem& I, const LAS unsigned char* scrb, int lane, const LAS float* g2 = nullptr, const bool use_g2 = false) {
    asm volatile("s_waitcnt vmcnt(0)" ::: "memory");
    f32x4 ga, gb; cv_gload(I, lane, ga, gb, g2, use_g2); cv_finish_g<0>(I, scrb, lane, ga, gb);
}
constexpr int CV_G2_OFF = 137728;
__device__ __forceinline__ void cv_load_g2(Frame& F, const Args& A) { const int t = F.wave * 64 + lane_id(); *(LAS f32x4*)(F.lds + CV_G2_OFF + t * 16) = *(const GAS f32x4*)(A.in[2] + DM + t * 4); }
__device__ __forceinline__ void cv_stream(Frame& F, const Args& A, int first, const int lim) {
    const int step = F.G * NWAVES; unsigned char* ws = F.ws;
    LAS unsigned char* sA = F.lds + CV_SCR_OFF + F.wave * CV_SCR_BYTES; LAS unsigned char* sB = F.lds + F.wave * CV_SCR_BYTES;
    int cur = first; int par = 0;
    if (cur < lim) { CvItem I; cv_decode(A, ws, cur, I); cv_issue(I, sA, lane_id()); }
    while (cur < lim) {
        const int nxt = cur + step; LAS unsigned char* sc = par ? sB : sA; LAS unsigned char* sn = par ? sA : sB;
        CvItem I; cv_decode(A, ws, cur, I); f32x4 ga, gb; cv_gload(I, lane_id(), ga, gb);
        if (nxt < lim) { CvItem J; cv_decode(A, ws, nxt, J); cv_issue(J, sn, lane_id()); cv_finish_g<8>(I, sc, lane_id(), ga, gb); }
        else cv_finish_g<0>(I, sc, lane_id(), ga, gb);
        cur = nxt; par ^= 1;
    }
}
__device__ __forceinline__ void norm_rows(Frame& F, const float* src, bf16* dst) {
    const int gw = F.vcu * NWAVES + F.wave, NGW = F.G * NWAVES;
    for (int m = gw; m < MTOK; m += NGW) {
        const GAS f32x4* xr = (const GAS f32x4*)(src + (size_t)m * DM) + lane_id();
        f32x4 v[8]; float s = 0.f;
#pragma unroll
        for (int j = 0; j < 8; ++j) { v[j] = xr[64 * j]; s += (v[j].x * v[j].x + v[j].y * v[j].y) + (v[j].z * v[j].z + v[j].w * v[j].w); }
        const float r = 1.0f / sqrtf(wave_sum(s) * (1.0f / DM) + RMS_EPS);
        GAS unsigned long long* o8 = (GAS unsigned long long*)(dst + (size_t)m * DM) + lane_id();
#pragma unroll
        for (int j = 0; j < 8; ++j) o8[64 * j] = (unsigned long long)cvtpk(v[j].x * r, v[j].y * r) | ((unsigned long long)cvtpk(v[j].z * r, v[j].w * r) << 32);
    }
}
__device__ __forceinline__ void norm_rows_i8(Frame& F, const float* src, unsigned char* dst, float* srow, const float* g) {
    const int gw = F.vcu * NWAVES + F.wave, NGW = F.G * NWAVES;
    for (int m = gw; m < MTOK; m += NGW) {
        const GAS f32x4* xr = (const GAS f32x4*)(src + (size_t)m * DM) + lane_id(); const GAS f32x4* gr = (const GAS f32x4*)g + lane_id();
        f32x4 v[8]; float s = 0.f;
#pragma unroll
        for (int j = 0; j < 8; ++j) { v[j] = xr[64 * j]; s += (v[j].x * v[j].x + v[j].y * v[j].y) + (v[j].z * v[j].z + v[j].w * v[j].w); }
        const float r = 1.0f / sqrtf(wave_sum(s) * (1.0f / DM) + RMS_EPS); float mx = 0.f;
#pragma unroll
        for (int j = 0; j < 8; ++j) { v[j] = v[j] * r * gr[64 * j]; mx = fmaxf(fmaxf(mx, fmaxf(fabsf(v[j].x), fabsf(v[j].y))), fmaxf(fabsf(v[j].z), fabsf(v[j].w))); }
#pragma unroll
        for (int o = 1; o < 64; o <<= 1) mx = fmaxf(mx, __shfl_xor(mx, o));
        mx = fmaxf(mx, 1e-20f); const float qs = 127.0f / mx;
        GAS unsigned* o4 = (GAS unsigned*)(dst + (size_t)m * DM) + lane_id();
#pragma unroll
        for (int j = 0; j < 8; ++j) { const int a0 = (int)rintf(v[j].x * qs), a1 = (int)rintf(v[j].y * qs), a2 = (int)rintf(v[j].z * qs), a3 = (int)rintf(v[j].w * qs);
            o4[64 * j] = (unsigned)(a0 & 0xff) | ((unsigned)(a1 & 0xff) << 8) | ((unsigned)(a2 & 0xff) << 16) | ((unsigned)a3 << 24); }
        if (lane_id() == 0) srow[m] = mx * (1.0f / 127.0f);
    }
}
__device__ __forceinline__ void p0_prologue(Frame& F, const Args& A) {
    LAS unsigned char* scr = F.lds + CV_SCR_OFF + F.wave * CV_SCR_BYTES;
    const int gw = F.vcu * NWAVES + F.wave, NGW = F.G * NWAVES;
    unsigned char* ws = F.ws;
    cv_stream(F, A, gw, CV_EARLY);
    { const int gt = F.vcu * NWAVES * 64 + (F.wave * 64 + lane_id()); if (gt < DM * NE) { const int k = gt / NE, e = gt % NE; ((float*)(ws + WS_WRG))[e * DM + k] = A.in[2][DM + k] * A.in[12][gt]; } }
    norm_rows(F, A.in[0], (bf16*)(ws + WS_Y));
    { float mx = 0.f; const size_t n4 = (size_t)DM * FFD / 4; const size_t tid0 = (size_t)(F.vcu * NWAVES + F.wave) * 64 + lane_id(), nth = (size_t)F.G * NWAVES * 64;
      for (size_t i = tid0; i < 2 * n4; i += nth) { const f32x4 v = (i < n4) ? ((const GAS f32x4*)A.in[9])[i] : ((const GAS f32x4*)A.in[10])[i - n4]; mx = fmaxf(fmaxf(mx, fmaxf(fabsf(v.x), fabsf(v.y))), fmaxf(fabsf(v.z), fabsf(v.w))); }
#pragma unroll
      for (int o = 1; o < 64; o <<= 1) mx = fmaxf(mx, __shfl_xor(mx, o));
      if (lane_id() == 0) atomicMax((unsigned*)(F.ctl + CW_AMAXW), __float_as_uint(mx)); }
}

__device__ __forceinline__ void kmean_phase(Frame& F) {
    const bf16* QK = (const bf16*)(F.ws + WS_QK); float* KM = (float*)(F.ws + WS_KMEAN);
    LAS float* part = (LAS float*)F.lds;
    for (int i = 0; i < 4; ++i) {
        const int item = F.vcu + F.G * i; if (item >= BATCH * NH * NBLK) break;
        const int b = item / (NH * NBLK), h = (item / NBLK) % NH, n = item % NBLK;
        const bf16* kp = QK + ((size_t)(b * SEQ + n * 256 + F.wave * 32)) * 4096 + 2048 + h * HD + 2 * lane_id();
        float s0 = 0.f, s1 = 0.f; unsigned kv[32];
#pragma unroll
        for (int r = 0; r < 32; ++r) kv[r] = *(const GAS unsigned*)(kp + (size_t)r * 4096);
#pragma unroll
        for (int r = 0; r < 32; ++r) { s0 += __uint_as_float(kv[r] << 16); s1 += __uint_as_float(kv[r] & 0xffff0000u); }
        part[F.wave * 128 + 2 * lane_id()] = s0; part[F.wave * 128 + 2 * lane_id() + 1] = s1;
        __syncthreads();
        if ((F.wave * 64 + lane_id()) < 128) { float s = 0.f;
#pragma unroll
            for (int w = 0; w < 8; ++w) s += part[w * 128 + (F.wave * 64 + lane_id())];
            KM[(size_t)item * HD + (F.wave * 64 + lane_id())] = s * (1.0f / 256.0f); }
        __syncthreads();
    }
}

constexpr int ATT_KB = 16384, ATT_VB = 128 * 136, ATT_K0 = 0, ATT_V0 = 2 * ATT_KB, ATT_FLAGS = ATT_V0 + 2 * ATT_VB;
__device__ __forceinline__ int kswz(int row, int colB) { return row * 256 + (colB ^ ((row & 15) << 4)); }
#define LDS_BARRIER() asm volatile("s_waitcnt lgkmcnt(0)\n\ts_barrier" ::: "memory")
struct TileRegs { v4u k0, k1, v0, v1; };
__device__ __forceinline__ void tile_load(TileRegs& T, const bf16* Kb, const bf16* Vtb, int kb, int tid) {
    const int key0 = tid >> 4, c16 = tid & 15, d0 = tid >> 3, c8 = tid & 7;
    T.k0 = *(const GAS v4u*)(Kb + (size_t)(kb + key0) * 4096 + c16 * 8);
    T.k1 = *(const GAS v4u*)(Kb + (size_t)(kb + key0 + 32) * 4096 + c16 * 8);
    T.v0 = *(const GAS v4u*)(Vtb + (size_t)d0 * MTOK + kb + c8 * 8);
    T.v1 = *(const GAS v4u*)(Vtb + (size_t)(d0 + 64) * MTOK + kb + c8 * 8);
}
__device__ __forceinline__ void tile_store(const TileRegs& T, LAS unsigned char* lds, int buf, int tid) {
    const int key0 = tid >> 4, c16 = tid & 15, d0 = tid >> 3, c8 = tid & 7;
    LAS unsigned char* Kl = lds + ATT_K0 + buf * ATT_KB; LAS unsigned char* Vl = lds + ATT_V0 + buf * ATT_VB;
    *(LAS v4u*)(Kl + kswz(key0, c16 * 16)) = T.k0;
    *(LAS v4u*)(Kl + kswz(key0 + 32, c16 * 16)) = T.k1;
    typedef unsigned v2u __attribute__((ext_vector_type(2)));
    LAS unsigned char* p0 = Vl + d0 * 136 + c8 * 16; LAS unsigned char* p1 = Vl + (d0 + 64) * 136 + c8 * 16;
    *(LAS v2u*)p0 = (v2u){T.v0.x, T.v0.y}; *(LAS v2u*)(p0 + 8) = (v2u){T.v0.z, T.v0.w};
    *(LAS v2u*)p1 = (v2u){T.v1.x, T.v1.y}; *(LAS v2u*)(p1 + 8) = (v2u){T.v1.z, T.v1.w};
}
#define QR_LANDED(q) asm volatile("" : "+v"(q[0]), "+v"(q[1]), "+v"(q[2]), "+v"(q[3]), "+v"(q[4]), "+v"(q[5]), "+v"(q[6]), "+v"(q[7]))
#define MFMA32(a, b, c) __builtin_amdgcn_mfma_f32_32x32x16_bf16((a), (b), (c), 0, 0, 0)
__device__ __forceinline__ void qk_tile(f32x16& p0, f32x16& p1, const LAS unsigned char* Kl, const bf16x8* qr, int r32, int hi) {
    p0 = (f32x16){}; p1 = (f32x16){};
    const int rowoff = r32 * 256, x = (r32 & 15) << 4;
#pragma unroll
    for (int ks = 0; ks < 8; ++ks) { const int off = rowoff + (((2 * ks + hi) * 16) ^ x);
        const bf16x8 a0 = *(const LAS bf16x8*)(Kl + off), a1 = *(const LAS bf16x8*)(Kl + off + 8192);
        p0 = MFMA32(a0, qr[ks], p0); p1 = MFMA32(a1, qr[ks], p1); }
}
__device__ __forceinline__ bf16x8 pack8(const f32x16& p, int b) {
    v4u w; w.x = cvtpk(p[b], p[b + 1]); w.y = cvtpk(p[b + 2], p[b + 3]); w.z = cvtpk(p[b + 4], p[b + 5]); w.w = cvtpk(p[b + 6], p[b + 7]); return __builtin_bit_cast(bf16x8, w);
}
__device__ __forceinline__ void pv_tile(f32x16* o, const LAS unsigned char* Vl, const f32x16& p0, const f32x16& p1, int r32, int hi) {
    const bf16x8 pb0 = pack8(p0, 0), pb1 = pack8(p0, 8), pb2 = pack8(p1, 0), pb3 = pack8(p1, 8);
    const LAS unsigned char* vp = Vl + r32 * 136 + hi * 8;
#pragma unroll
    for (int db = 0; db < 4; ++db) {
#pragma unroll
        for (int s = 0; s < 4; ++s) {
            const s16x4 lo = *(const LAS s16x4*)(vp + db * (32 * 136) + s * 32), h4 = *(const LAS s16x4*)(vp + db * (32 * 136) + s * 32 + 16);
            const bf16x8 a = (bf16x8){lo[0], lo[1], lo[2], lo[3], h4[0], h4[1], h4[2], h4[3]};
            o[db] = MFMA32(a, s == 0 ? pb0 : s == 1 ? pb1 : s == 2 ? pb2 : pb3, o[db]); } }
}
__device__ __forceinline__ void store_ot(const f32x16* o, float sc, bf16* orow, int hi) {
#pragma unroll
    for (int db = 0; db < 4; ++db)
#pragma unroll
        for (int g = 0; g < 4; ++g) { typedef unsigned v2u __attribute__((ext_vector_type(2)));
            v2u w; w.x = cvtpk(o[db][4 * g] * sc, o[db][4 * g + 1] * sc); w.y = cvtpk(o[db][4 * g + 2] * sc, o[db][4 * g + 3] * sc);
            *(GAS v2u*)(orow + db * 32 + g * 8 + hi * 4) = w; }
}

constexpr int CW_GCNT = 32768;
constexpr int PB_STRIDE = 264;
constexpr int S2_PRE_OFF = 135424;
__device__ __forceinline__ void moba_select(Frame& F, int b, int h, int j) {
    const bf16* QK = (const bf16*)(F.ws + WS_QK); const float* KM = (const float*)(F.ws + WS_KMEAN);
    unsigned short* LIST = (unsigned short*)(F.ws + WS_LIST); unsigned* GCNT = (unsigned*)(F.ws + WS_CTL) + CW_GCNT;
    const int lane = lane_id(), w = F.wave, r32 = lane & 31, hi = lane >> 5, tid = w * 64 + lane;
    const int tq = j * 256 + 32 * w + r32, bh = b * NH + h;
    LAS int* cl = (LAS int*)F.lds; LAS int* gb = cl + 32;
    if (tid < 32) cl[tid] = 0;
    const bf16* Qrow = QK + (size_t)(b * SEQ + tq) * 4096 + h * HD;
    bf16x8 qr[8];
#pragma unroll
    for (int ks = 0; ks < 8; ++ks) qr[ks] = *(const GAS bf16x8*)(Qrow + 16 * ks + 8 * hi);
    const float* kmrow = KM + ((size_t)(bh * NBLK + r32)) * HD;
    f32x16 g = (f32x16){};
#pragma unroll
    for (int ks = 0; ks < 8; ++ks) {
        const f32x4 a = *(const GAS f32x4*)(kmrow + 16 * ks + 8 * hi), c = *(const GAS f32x4*)(kmrow + 16 * ks + 8 * hi + 4);
        const float v[8] = {a.x, a.y, a.z, a.w, c.x, c.y, c.z, c.w}; bf16x8 kh, kl;
#pragma unroll
        for (int e = 0; e < 8; ++e) { const unsigned hb = f2bf(v[e]); kh[e] = (short)hb; kl[e] = (short)f2bf(v[e] - bf2f((unsigned short)hb)); }
        g = MFMA32(kh, qr[ks], g); g = MFMA32(kl, qr[ks], g);
    }
    __syncthreads();
    const float NEG = -__builtin_inff();
    float v[16]; int sn[3], pos[3];
#pragma unroll
    for (int r = 0; r < 16; ++r) { const int n = (r & 3) + 8 * (r >> 2) + 4 * hi; v[r] = (n < j) ? g[r] : NEG; }
#pragma unroll
    for (int it = 0; it < 3; ++it) {
        float lm = NEG; int ln = 0;
#pragma unroll
        for (int r = 0; r < 16; ++r) { const int n = (r & 3) + 8 * (r >> 2) + 4 * hi; if (v[r] > lm) { lm = v[r]; ln = n; } }
        float lmB, lnBf; const float lmA = swap_lo(lm, lmB); const float lnAf = swap_lo((float)ln, lnBf);
        const int lnA = (int)lnAf, lnB = (int)lnBf;
        const bool pickA = (lmA > lmB) || (lmA == lmB && lnA < lnB);
        const float wm = pickA ? lmA : lmB; const int wn = pickA ? lnA : lnB;
        const bool ok = wm > NEG;
        sn[it] = ok ? wn : -1; pos[it] = 0;
        if (ok && hi == 0) pos[it] = __hip_atomic_fetch_add(&cl[wn], 1, __ATOMIC_RELAXED, __HIP_MEMORY_SCOPE_WORKGROUP);
        const bool mine = (pickA == (hi == 0));
#pragma unroll
        for (int r = 0; r < 16; ++r) { const int n = (r & 3) + 8 * (r >> 2) + 4 * hi; if (mine && n == wn) v[r] = NEG; }
    }
    __syncthreads();
    if (tid < 32) gb[tid] = cl[tid] ? (int)atomicAdd(&GCNT[bh * NBLK + tid], (unsigned)cl[tid]) : 0;
    __syncthreads();
    if (hi == 0) {
#pragma unroll
        for (int it = 0; it < 3; ++it) if (sn[it] >= 0) LIST[(size_t)(bh * NBLK + sn[it]) * SEQ + gb[sn[it]] + pos[it]] = (unsigned short)(tq | (it << 13));
    }
    __syncthreads();
}
template <int KIND> __device__ __forceinline__ void moba_sweep(Frame& F, const Args& A, CvItem& cvI, int& cv_prev, int& cv_next, const int cv_lim, int b, int h, int blk, int tq, bool valid, int kslot) {
    const bf16* QK = (const bf16*)(F.ws + WS_QK); const bf16* VT = (const bf16*)(F.ws + WS_VT); bf16* AO = (bf16*)(F.ws + WS_AO); unsigned char* PB = F.ws + WS_PB;
    const int lane = lane_id(), w = F.wave, r32 = lane & 31, hi = lane >> 5, tid = w * 64 + lane;
    const int t0 = blk * 256;
    const bf16* Qrow = QK + (size_t)(b * SEQ + tq) * 4096 + h * HD;
    const bf16* Kb = QK + (size_t)(b * SEQ) * 4096 + 2048 + h * HD;
    const bf16* Vtb = VT + (size_t)(h * HD) * MTOK + b * SEQ;
    bf16x8 qr[8];
#pragma unroll
    for (int ks = 0; ks < 8; ++ks) qr[ks] = *(const GAS bf16x8*)(Qrow + 16 * ks + 8 * hi);
    const float slope2 = exp2f(-0.5f * (float)(h + 1)) * 1.4426950408889634f;
    const float C2 = 0.08838834764831845f * 1.4426950408889634f;
    float m = -1e30f, l = 0.f; f32x16 o[4] = {};
    TileRegs T;
    tile_load(T, Kb, Vtb, t0 + 192, tid);
    { const bool ok = cv_next < cv_lim; cv_decode(A, F.ws, ok ? cv_next : CV_EARLY, cvI, ok); cv_issue(cvI, F.lds + CV_SCR_OFF + w * CV_SCR_BYTES, lane); cv_prev = ok ? cv_next : CV_NONE; cv_next += ok ? F.G * NWAVES : 0; }
    tile_store(T, F.lds, 0, tid);
    LDS_BARRIER();
    QR_LANDED(qr);
#pragma unroll 1
    for (int t = 0; t < 4; ++t) {
        const int kb = t0 + 192 - 64 * t, buf = t & 1;
        if (t + 1 < 4) tile_load(T, Kb, Vtb, kb - 64, tid);
        asm volatile("" ::: "memory");
        bool act = true, needmask = false;
        if (KIND == 3) { act = (kb <= t0 + 32 * w + 31); needmask = (kb + 63 > t0 + 32 * w); }
        if (act) {
            f32x16 p0, p1;
            qk_tile(p0, p1, F.lds + ATT_K0 + buf * ATT_KB, qr, r32, hi);
            const float NEG = -__builtin_inff();
            const float T0 = slope2 * (float)(kb + 4 * hi - tq), T1 = T0 + 32.0f * slope2;
            const int dq = tq - kb - 4 * hi;
            float mx0 = NEG, mx1 = NEG; float s2v = slope2; asm volatile("" : "+v"(s2v));
#pragma unroll
            for (int r = 0; r < 16; ++r) { const int c = (r & 3) + 8 * (r >> 2); const float bc = s2v * (float)c;
                float x0 = fmaf(p0[r], C2, bc), x1 = fmaf(p1[r], C2, bc);
                if (needmask) { if (c > dq) x0 = NEG; if (c + 32 > dq) x1 = NEG; }
                p0[r] = x0; p1[r] = x1; mx0 = fmaxf(mx0, x0); mx1 = fmaxf(mx1, x1); }
            float cand = fmaxf(mx0 + T0, mx1 + T1);
            { float cb; const float ca = swap_lo(cand, cb); cand = fmaxf(ca, cb); }
            if (__any(cand > m + 8.0f)) {
                const float mn = fmaxf(m, cand), alpha = __builtin_amdgcn_exp2f(m - mn);
                l *= alpha; m = mn;
#pragma unroll
                for (int db = 0; db < 4; ++db)
#pragma unroll
                    for (int r = 0; r < 16; ++r) o[db][r] *= alpha;
            }
            const float d0 = T0 - m, d1 = T1 - m; float ps = 0.f;
#pragma unroll
            for (int r = 0; r < 16; ++r) { p0[r] = __builtin_amdgcn_exp2f(p0[r] + d0); p1[r] = __builtin_amdgcn_exp2f(p1[r] + d1); ps += p0[r] + p1[r]; }
            l += ps;
            pv_tile(o, F.lds + ATT_V0 + buf * ATT_VB, p0, p1, r32, hi);
        }
        if (cv_prev < CV_NONE) cv_finish(cvI, F.lds + CV_SCR_OFF + w * CV_SCR_BYTES, lane, (const LAS float*)(F.lds + CV_G2_OFF), true);
        if (t + 1 < 4) tile_store(T, F.lds, buf ^ 1, tid);
        if (t + 1 < 4 && cv_next < cv_lim) { cv_decode(A, F.ws, cv_next, cvI); cv_issue(cvI, F.lds + CV_SCR_OFF + w * CV_SCR_BYTES, lane); cv_prev = cv_next; cv_next += F.G * NWAVES; } else cv_prev = CV_NONE;
        LDS_BARRIER();
    }
    { float lb; const float la = swap_lo(l, lb); l = la + lb; }
    const size_t qidx = (size_t)((b * NH + h) * SEQ + tq) * 3;
    if (KIND == 2) {
        if (valid) { unsigned char* pb = PB + (qidx + kslot) * PB_STRIDE; typedef unsigned v2u __attribute__((ext_vector_type(2)));
#pragma unroll
            for (int db = 0; db < 4; ++db)
#pragma unroll
                for (int g = 0; g < 4; ++g) { v2u wv; wv.x = cvtpk(o[db][4 * g], o[db][4 * g + 1]); wv.y = cvtpk(o[db][4 * g + 2], o[db][4 * g + 3]); *(GAS v2u*)(pb + (db * 32 + g * 8 + hi * 4) * 2) = wv; }
            if (hi == 0) { *(GAS f32x2v*)(pb + 256) = (f32x2v){m, l}; } }
    } else {
        const int nv = blk < 3 ? blk : 3;
        for (int k = 0; k < nv; ++k) { const unsigned char* pb = PB + (qidx + k) * PB_STRIDE; typedef unsigned v2u __attribute__((ext_vector_type(2)));
            const f32x2v ml = *(const GAS f32x2v*)(pb + 256);
            const float mk = ml.x, lk = ml.y, M = fmaxf(m, mk), sa = __builtin_amdgcn_exp2f(m - M), sb = __builtin_amdgcn_exp2f(mk - M);
            l = l * sa + lk * sb; m = M;
#pragma unroll
            for (int db = 0; db < 4; ++db)
#pragma unroll
                for (int g = 0; g < 4; ++g) { const v2u pv = *(const GAS v2u*)(pb + (db * 32 + g * 8 + hi * 4) * 2);
                    o[db][4 * g] = o[db][4 * g] * sa + __uint_as_float(pv.x << 16) * sb; o[db][4 * g + 1] = o[db][4 * g + 1] * sa + __uint_as_float(pv.x & 0xffff0000u) * sb; o[db][4 * g + 2] = o[db][4 * g + 2] * sa + __uint_as_float(pv.y << 16) * sb; o[db][4 * g + 3] = o[db][4 * g + 3] * sa + __uint_as_float(pv.y & 0xffff0000u) * sb; } }
        store_ot(o, 1.0f / l, AO + (size_t)(b * SEQ + tq) * DM + h * HD, hi);
    }
    __syncthreads();
}

__device__ __forceinline__ void sb_unit(Frame& F, const Args& A, CvItem& cvI, int& cv_prev, int& cv_next, const int cv_lim, int b, int h, int qb) {
    const bf16* QK = (const bf16*)(F.ws + WS_QK); const bf16* VT = (const bf16*)(F.ws + WS_VT); bf16* AO = (bf16*)(F.ws + WS_AO);
    const int tid = (F.wave * 64 + lane_id()), lane = lane_id(), w = F.wave, r32 = lane & 31, hi = lane >> 5;
    const int t0 = qb * 256, tq = t0 + 32 * w + r32;
    const bf16* Qrow = QK + (size_t)(b * SEQ + tq) * 4096 + h * HD;
    const bf16* Kb = QK + (size_t)(b * SEQ) * 4096 + 2048 + h * HD;
    const bf16* Vtb = VT + (size_t)(h * HD) * MTOK + b * SEQ;
    bf16x8 qr[8];
#pragma unroll
    for (int ks = 0; ks < 8; ++ks) qr[ks] = *(const GAS bf16x8*)(Qrow + 16 * ks + 8 * hi);
    const float C2 = 0.08838834764831845f * 1.4426950408889634f;
    float R = 0.f; f32x16 o[4] = {}; bool done = false;
    volatile LAS unsigned* flags = (volatile LAS unsigned*)(F.lds + ATT_FLAGS);
    TileRegs T;
    const int ktop = 4 * qb + 3;
    tile_load(T, Kb, Vtb, 64 * ktop, tid); tile_store(T, F.lds, 0, tid);
    __syncthreads();
    QR_LANDED(qr);
    for (int it = 0;; ++it) {
        const int kb = 64 * (ktop - it), buf = it & 1; const bool more = kb > 0;
        if (more) tile_load(T, Kb, Vtb, kb - 64, tid);
        const bool act = !done && (kb < t0 + 32 * w + 31);
        if (act) {
            const bool needmask = (kb + 63 >= t0 + 32 * w);
            f32x16 p0, p1;
            qk_tile(p0, p1, F.lds + ATT_K0 + buf * ATT_KB, qr, r32, hi);
            const int dq = tq - kb - 4 * hi;
            f32x16 k0, k1;
            float s0[4], s1[4];
#pragma unroll
            for (int g = 0; g < 4; ++g) { s0[g] = 0.f; s1[g] = 0.f; }
#pragma unroll
            for (int r = 0; r < 16; ++r) { const int c = (r & 3) + 8 * (r >> 2);
                const float u0 = p0[r] * C2, u1 = p1[r] * C2;
                float a0 = fminf(-u0, 0.f) - __builtin_amdgcn_logf(1.0f + __builtin_amdgcn_exp2f(-fabsf(u0)));
                float a1 = fminf(-u1, 0.f) - __builtin_amdgcn_logf(1.0f + __builtin_amdgcn_exp2f(-fabsf(u1)));
                if (needmask) { if (!(c < dq)) a0 = 0.f; if (!(c + 32 < dq)) a1 = 0.f; }
                p0[r] = u0; p1[r] = u1; k0[r] = a0; k1[r] = a1; s0[r >> 2] += a0; s1[r >> 2] += a1; }
            float run = R, off0[4], off1[4];
#pragma unroll
            for (int g = 3; g >= 0; --g) { float sb; const float sa = swap_lo(s1[g], sb); const float o_hi1 = run; run += sb; const float o_hi0 = run; run += sa; off1[g] = hi ? o_hi1 : o_hi0; }
#pragma unroll
            for (int g = 3; g >= 0; --g) { float sb; const float sa = swap_lo(s0[g], sb); const float o_hi1 = run; run += sb; const float o_hi0 = run; run += sa; off0[g] = hi ? o_hi1 : o_hi0; }
            R = run;
#pragma unroll
            for (int g = 0; g < 4; ++g) { float c0 = off0[g], c1 = off1[g];
#pragma unroll
                for (int i = 3; i >= 0; --i) { const int r = 4 * g + i, c = (r & 3) + 8 * (r >> 2);
                    c0 += k0[r]; c1 += k1[r];
                    float w0 = __builtin_amdgcn_exp2f(p0[r] + c0), w1 = __builtin_amdgcn_exp2f(p1[r] + c1);
                    if (needmask) { if (!(c < dq)) w0 = 0.f; if (!(c + 32 < dq)) w1 = 0.f; }
                    p0[r] = w0; p1[r] = w1; } }
            pv_tile(o, F.lds + ATT_V0 + buf * ATT_VB, p0, p1, r32, hi);
            done = __all(R < -152.0f);
        }
        if (lane == 0) flags[(it & 1) * 8 + w] = done ? 1u : 0u;
        if (cv_prev < CV_NONE) cv_finish(cvI, F.lds + CV_SCR_OFF + w * CV_SCR_BYTES, lane, (const LAS float*)(F.lds + CV_G2_OFF), true);
        if (more) tile_store(T, F.lds, buf ^ 1, tid);
        if (cv_next < cv_lim) { cv_decode(A, F.ws, cv_next, cvI); cv_issue(cvI, F.lds + CV_SCR_OFF + w * CV_SCR_BYTES, lane); cv_prev = cv_next; cv_next += F.G * NWAVES; } else cv_prev = CV_NONE;
        LDS_BARRIER();
        unsigned nd = 0;
#pragma unroll
        for (int i = 0; i < 8; ++i) nd += flags[(it & 1) * 8 + i];
        if (nd == 8u || !more) break;
    }
    store_ot(o, 1.0f, AO + (size_t)(b * SEQ + tq) * DM + h * HD, hi);
    __syncthreads();
}

__device__ __forceinline__ void moe_tail_reduce(unsigned char* ws) {
    const int cid = (int)blockIdx.x;
    const int* META = (const int*)(ws + WS_META); const int P = __builtin_amdgcn_readfirstlane(META[8]);
    const int nwg = P * (DM / 256), G = (int)gridDim.x, full = nwg / G, tpx = (nwg - full * G) / 8;
    const int x = cid % 8, j = cid / 8, tu = j >> 2, q = j & 3;
    if (G != 256 || (nwg % 8) != 0 || tpx > 8 || tu >= tpx) return;
    pg8::StaticOrder so; so.init(P * 256, DM, G, cid); pg8::Unit u; if (!so.at((long)full * G + tu * 8 + x, u)) return;
    const float* T = (const float*)(ws + WS_SLAB) + (size_t)((x * 8 + tu) * 4) * 65536; bf16* YS = (bf16*)(ws + WS_YS);
    const int tid = (int)threadIdx.x;
#pragma unroll
    for (int i = 0; i < 8; ++i) { const int idx = tid + 512 * i, row = 64 * q + (idx >> 6), c4 = idx & 63;
        const GAS f32x4* p = (const GAS f32x4*)(T + row * 256 + c4 * 4);
        const f32x4 s = (p[0] + p[65536 / 4]) + (p[2 * 65536 / 4] + p[3 * 65536 / 4]);
        typedef unsigned v2u __attribute__((ext_vector_type(2)));
        v2u w; w.x = cvtpk(s.x, s.y); w.y = cvtpk(s.z, s.w);
        *(GAS v2u*)(YS + (size_t)(u.pm * 256 + row) * DM + u.pn * 256 + c4 * 4) = w; }
}

__device__ __forceinline__ void router_phase(Frame& F) {
    const float* H = (const float*)(F.ws + WS_H); bf16* Y = (bf16*)(F.ws + WS_Y);
    int* TOKE = (int*)(F.ws + WS_TOKE); float* TOKG = (float*)(F.ws + WS_TOKG); int* TOKR = (int*)(F.ws + WS_TOKR); int* CNT = (int*)(F.ws + WS_CNT);
    LAS float* wl = (LAS float*)F.lds;
    LAS int* te = (LAS int*)(F.lds + 65536);
    { const GAS f32x4* src = (const GAS f32x4*)(F.ws + WS_WRG); LAS f32x4* dst = (LAS f32x4*)wl; for (int i = (F.wave * 64 + lane_id()); i < NE * DM / 4; i += NWAVES * 64) dst[i] = src[i]; }
    __syncthreads();
    const int rows_per_wg = MTOK / F.G, rows_per_wave = rows_per_wg / NWAVES;
    const int row0 = F.vcu * rows_per_wg + F.wave * rows_per_wave;
    for (int i = 0; i < rows_per_wave; ++i) {
        const int m = row0 + i;
        const GAS f32x4* xr = (const GAS f32x4*)(H + (size_t)m * DM) + lane_id();
        f32x4 v[8]; float s = 0.f;
#pragma unroll
        for (int j = 0; j < 8; ++j) { v[j] = xr[64 * j]; s += (v[j].x * v[j].x + v[j].y * v[j].y) + (v[j].z * v[j].z + v[j].w * v[j].w); }
        const float r = 1.0f / sqrtf(wave_sum(s) * (1.0f / DM) + RMS_EPS);
        GAS unsigned long long* o8 = (GAS unsigned long long*)(Y + (size_t)m * DM) + lane_id();
#pragma unroll
        for (int j = 0; j < 8; ++j) o8[64 * j] = (unsigned long long)cvtpk(v[j].x * r, v[j].y * r) | ((unsigned long long)cvtpk(v[j].z * r, v[j].w * r) << 32);
        float lg[NE];
#pragma unroll
        for (int e = 0; e < NE; ++e) { float a = 0.f;
#pragma unroll
            for (int j = 0; j < 8; ++j) { const f32x4 wv = *(const LAS f32x4*)(wl + e * DM + 256 * j + 4 * lane_id()); a += (v[j].x * wv.x + v[j].y * wv.y) + (v[j].z * wv.z + v[j].w * wv.w); }
            lg[e] = wave_sum(a) * r; }
        int i0 = 0; float l0 = lg[0];
#pragma unroll
        for (int e = 1; e < NE; ++e) if (lg[e] > l0) { l0 = lg[e]; i0 = e; }
        int i1 = -1; float l1 = -__builtin_inff();
#pragma unroll
        for (int e = 0; e < NE; ++e) if (e != i0 && lg[e] > l1) { l1 = lg[e]; i1 = e; }
        const float ex = expf(l1 - l0), g0 = 1.0f / (1.0f + ex), g1 = ex / (1.0f + ex);
        if (lane_id() == 0) { TOKE[2 * m] = i0; TOKE[2 * m + 1] = i1; TOKG[2 * m] = g0; TOKG[2 * m + 1] = g1; const int lr = m - F.vcu * rows_per_wg; te[2 * lr] = i0; te[2 * lr + 1] = i1; }
    }
    __syncthreads();
    if ((F.wave * 64 + lane_id()) < NE) { int c = 0; const int mb = F.vcu * rows_per_wg;
        for (int t = 0; t < rows_per_wg; ++t) {
#pragma unroll
            for (int k = 0; k < 2; ++k) if (te[2 * t + k] == (F.wave * 64 + lane_id())) { TOKR[2 * (mb + t) + k] = c; ++c; } }
        CNT[F.vcu * NE + (F.wave * 64 + lane_id())] = c; }
    __syncthreads();
}
__device__ __forceinline__ void scatter_phase(Frame& F) {
    const bf16* Y = (const bf16*)(F.ws + WS_Y); unsigned char* XS = (unsigned char*)(F.ws + WS_XS);
    const int* TOKE = (const int*)(F.ws + WS_TOKE); const int* TOKR = (const int*)(F.ws + WS_TOKR); int* TOKP = (int*)(F.ws + WS_TOKP); const int* CNT = (const int*)(F.ws + WS_CNT); int* META = (int*)(F.ws + WS_META);
    LAS int* cl = (LAS int*)F.lds;
    LAS int* tot = (LAS int*)(F.lds + 16384);
    for (int i = (F.wave * 64 + lane_id()); i < F.G * NE; i += NWAVES * 64) cl[i] = CNT[i];
    __syncthreads();
    if ((F.wave * 64 + lane_id()) < NE) { int t = 0, p = 0; for (int g = 0; g < F.G; ++g) { const int c = cl[g * NE + (F.wave * 64 + lane_id())]; if (g < F.vcu) p += c; t += c; } tot[(F.wave * 64 + lane_id())] = t; tot[8 + (F.wave * 64 + lane_id())] = p; }
    __syncthreads();
    if ((F.wave * 64 + lane_id()) == 0) { int ts = 0; for (int e = 0; e < NE; ++e) { tot[16 + e] = ts; tot[32 + e] = ts * 256 + tot[8 + e]; ts += (tot[e] + 255) / 256; } tot[16 + NE] = ts;
        if (F.vcu == 0) { for (int e = 0; e <= NE; ++e) META[e] = tot[16 + e]; } }
    __syncthreads();
    const int rows_per_wg = MTOK / F.G, rows_per_wave = rows_per_wg / NWAVES;
    const int row0 = F.vcu * rows_per_wg + F.wave * rows_per_wave;
    for (int i = 0; i < rows_per_wave; ++i) { const int m = row0 + i;
        const GAS v4u* src = (const GAS v4u*)(Y + (size_t)m * DM) + lane_id();
        typedef unsigned v2u __attribute__((ext_vector_type(2)));
        v2u q[4];
#pragma unroll
        for (int j = 0; j < 4; ++j) { const v4u v = src[64 * j];
            q[j].x = pg8::pk4_fp8(__uint_as_float(v.x << 16) * F8_ASCALE, __uint_as_float(v.x & 0xffff0000u) * F8_ASCALE, __uint_as_float(v.y << 16) * F8_ASCALE, __uint_as_float(v.y & 0xffff0000u) * F8_ASCALE);
            q[j].y = pg8::pk4_fp8(__uint_as_float(v.z << 16) * F8_ASCALE, __uint_as_float(v.z & 0xffff0000u) * F8_ASCALE, __uint_as_float(v.w << 16) * F8_ASCALE, __uint_as_float(v.w & 0xffff0000u) * F8_ASCALE); }
#pragma unroll
        for (int k = 0; k < 2; ++k) { const int e = TOKE[2 * m + k], pos = tot[32 + e] + TOKR[2 * m + k];
            if (lane_id() == 0) TOKP[2 * m + k] = pos;
            GAS v2u* dst = (GAS v2u*)(XS + (size_t)pos * DM) + lane_id();
#pragma unroll
            for (int j = 0; j < 4; ++j) dst[64 * j] = q[j]; } }
    __syncthreads();
}
__device__ __forceinline__ void combine_phase(Frame& F, const float* gf, float* outp) {
    const int lane_c = lane_id_fresh();
    const float* H = (const float*)(F.ws + WS_H); const bf16* YS = (const bf16*)(F.ws + WS_YS); const int* TOKP = (const int*)(F.ws + WS_TOKP); const float* TOKG = (const float*)(F.ws + WS_TOKG);
    const int gw = F.vcu * NWAVES + F.wave, NGW = F.G * NWAVES;
    for (int m = gw; m < MTOK; m += NGW) {
        const int p0 = TOKP[2 * m], p1 = TOKP[2 * m + 1]; const float g0 = TOKG[2 * m], g1 = TOKG[2 * m + 1];
        const GAS f32x4* xr = (const GAS f32x4*)(H + (size_t)m * DM) + lane_c; typedef unsigned v2u __attribute__((ext_vector_type(2)));
        const GAS v2u* y0 = (const GAS v2u*)(YS + (size_t)p0 * DM) + lane_c; const GAS v2u* y1 = (const GAS v2u*)(YS + (size_t)p1 * DM) + lane_c;
        f32x4 v[8]; float s = 0.f;
#pragma unroll
        for (int j = 0; j < 8; ++j) { const v2u a0 = y0[64 * j], a1 = y1[64 * j];
            const f32x4 e0 = {__uint_as_float(a0.x << 16), __uint_as_float(a0.x & 0xffff0000u), __uint_as_float(a0.y << 16), __uint_as_float(a0.y & 0xffff0000u)}, e1 = {__uint_as_float(a1.x << 16), __uint_as_float(a1.x & 0xffff0000u), __uint_as_float(a1.y << 16), __uint_as_float(a1.y & 0xffff0000u)};
            v[j] = xr[64 * j] + (e0 * g0 + e1 * g1); s += (v[j].x * v[j].x + v[j].y * v[j].y) + (v[j].z * v[j].z + v[j].w * v[j].w); }
        const float r = 1.0f / sqrtf(wave_sum_l(s, lane_c) * (1.0f / DM) + RMS_EPS);
        GAS f32x4* orow = (GAS f32x4*)(outp + (size_t)m * DM) + lane_c; const GAS f32x4* gr = (const GAS f32x4*)gf + lane_c;
#pragma unroll
        for (int j = 0; j < 8; ++j) orow[64 * j] = v[j] * r * gr[64 * j];
    }
}

__global__ void __launch_bounds__(NWAVES * 64, 2) yoco_fwd(Args args) {
    extern __shared__ __attribute__((aligned(16))) unsigned char lds[];
    Frame F;
    F.lds = (LAS unsigned char*)lds;
    F.MISC = (volatile LAS unsigned*)(F.lds + MISC_OFF);
    F.wave = __builtin_amdgcn_readfirstlane((int)threadIdx.x >> 6);
    F.G = gridDim.x; { const int bx = blockIdx.x; F.vcu = (F.G % 8 == 0) ? (bx % 8) * (F.G / 8) + bx / 8 : bx; }
    unsigned char* ws = args.ws; F.ws = ws;

    F.ctl = (gu32*)(ws + WS_CTL);
    for (int u = (F.wave * 64 + lane_id()); u < (LDS_BYTES - MISC_OFF) / 4; u += NWAVES * 64) ((LAS unsigned*)(F.lds + MISC_OFF))[u] = 0u;
    __syncthreads();
    XcdBarrier bar; bar.bar = (unsigned*)(F.ctl + CW_BAR); bar.x = 0; bar.st = nullptr; bar.wave = F.wave;
    if (N_LAUNCHES == 1) bar = xcd_barrier_post((unsigned*)(F.ctl + CW_BAR), F.MISC + 8, F.wave);
#define GRID_BAR() do { if (N_LAUNCHES == 1) { XcdBarrier b_; b_.bar = (unsigned*)((gu32*)(F.ws + WS_CTL) + CW_BAR); b_.x = bar.x; b_.wave = F.wave; b_.st = (volatile LAS unsigned*)(F.lds + MISC_OFF) + 8; xcd_barrier(b_); } } while (0)
    const int lo = args.ph_lo, hi = args.ph_hi;
#if defined(DBG) && DBG
    if (lo >= 1000) { dbg_check(F, args, lo - 1000); return; }
#endif
#define IN(k) (lo <= (k) && (k) < hi)
#ifndef PROBE_REP_PHASE
#define PROBE_REP_PHASE -1
#endif
#define REPN(k) ((k) == PROBE_REP_PHASE ? 2 : 1)
#ifdef PROBE_T
#define PT_STAMP(slot) do { if (blockIdx.x == 0 && threadIdx.x == 0) __hip_atomic_store((unsigned*)((gu32*)(F.ws + WS_CTL) + 8 + (slot)), (unsigned)__builtin_amdgcn_s_memrealtime(), __ATOMIC_RELAXED, __HIP_MEMORY_SCOPE_AGENT); } while (0)
#define SEAM(k) do { if (IN(k) && IN((k) + 1)) GRID_BAR(); if ((k) + 1 == PROBE_T) PT_STAMP(0); if ((k) + 1 == PROBE_T_END) PT_STAMP(1); } while (0)
#else
#define SEAM(k) do { if (IN(k) && IN((k) + 1)) GRID_BAR(); } while (0)
#endif
    LAS unsigned char* ring = F.lds;
    const int cid = (int)blockIdx.x;

    if (IN(0)) { p0_prologue(F, args); } SEAM(0);
    if (IN(1)) {
        { pg8::Gemm g{(const bf16*)(ws + WS_Y), (const bf16*)(ws + WS_WQK0), MTOK, 4096, DM}; pg8::StaticOrder S; S.init(MTOK, 4096, F.G, cid);
          pg8::EpiBf16Kmean E{(bf16*)(ws + WS_QK), 4096, (float*)(ws + WS_KMEAN)}; pg8::gemm_phase<pg8::EpiBf16Kmean, pg8::StaticOrder, false, true>(ring, g, S, E, F.wave); }
        { pg8::Gemm g{(const bf16*)(ws + WS_WV0), (const bf16*)(ws + WS_Y), DM, MTOK, DM}; pg8::StaticOrder S; S.init(DM, MTOK, F.G, cid);
          pg8::EpiBf16 E{(bf16*)(ws + WS_VT), MTOK}; pg8::gemm_phase<pg8::EpiBf16, pg8::StaticOrder, false, true>(ring, g, S, E, F.wave); }
    } SEAM(1);
    if (IN(3)) {
        const int v = F.vcu, bh = v >> 3;
        for (int i = 0; i < 4; ++i) { const int j = (v & 7) + 8 * i; if (j > 0) moba_select(F, bh / NH, bh % NH, j); }
    } SEAM(3);
    int cv_prev = CV_NONE, cv_next = CV_EARLY + F.vcu * NWAVES + F.wave;
    const int cv_split = CV_EARLY + CV_SPLIT_PER_WAVE * F.G * NWAVES;
    CvItem cvI;
    if (IN(4)) {
        const unsigned* GCNT = (const unsigned*)(ws + WS_CTL) + CW_GCNT; const unsigned short* LIST = (const unsigned short*)(ws + WS_LIST);
        LAS unsigned short* pre = (LAS unsigned short*)(F.lds + S2_PRE_OFF);
        cv_load_g2(F, args);
        for (int i = F.wave * 64 + lane_id(); i < BATCH * NH * NBLK; i += NWAVES * 64) pre[i + 1] = (unsigned short)((GCNT[i] + 255u) >> 8);
        __syncthreads();
        if (F.wave == 0) { const int ln = lane_id(); int cv[16]; int s = 0;
#pragma unroll
            for (int i = 0; i < 16; ++i) { cv[i] = pre[1 + 16 * ln + i]; s += cv[i]; }
            int incl = s;
#pragma unroll
            for (int o = 1; o < 64; o <<= 1) { const int t = __shfl_up(incl, o); if (ln >= o) incl += t; }
            int run = incl - s;
#pragma unroll
            for (int i = 0; i < 16; ++i) { run += cv[i]; pre[1 + 16 * ln + i] = (unsigned short)run; }
            if (ln == 0) pre[0] = 0; }
        __syncthreads();
        const int T = pre[BATCH * NH * NBLK];
        int item = F.vcu; int c_idx = 0, c_c = 0; unsigned c_cnt = 0, c_val = 0;
#define S2_FETCH(it_, idx_, c_, cnt_, val_) do { int lo_ = 0, hi_ = BATCH * NH * NBLK;                         \
            while (hi_ - lo_ > 1) { const int mid = (lo_ + hi_) >> 1; if ((int)pre[mid] <= (it_)) lo_ = mid; else hi_ = mid; } \
            idx_ = __builtin_amdgcn_readfirstlane(lo_); c_ = (it_) - (int)pre[idx_]; cnt_ = GCNT[idx_]; \
            val_ = LIST[(size_t)idx_ * SEQ + 256 * c_ + 32 * F.wave + (lane_id() & 31)]; } while (0)
        if (item < T) S2_FETCH(item, c_idx, c_c, c_cnt, c_val);
        while (item < T) {
            const int nitem = item + F.G; int n_idx = 0, n_c = 0; unsigned n_cnt = 0, n_val = 0;
            if (nitem < T) S2_FETCH(nitem, n_idx, n_c, n_cnt, n_val);
            const int bh = c_idx >> 5, n = c_idx & 31; const bool valid = (unsigned)(256 * c_c + 32 * F.wave + (lane_id() & 31)) < c_cnt;
            moba_sweep<2>(F, args, cvI, cv_prev, cv_next, cv_split - 16 * F.G * NWAVES, bh / NH, bh % NH, n, (int)(c_val & 8191u), valid, (int)((c_val >> 13) & 3u));
            item = nitem; c_idx = n_idx; c_c = n_c; c_cnt = n_cnt; c_val = n_val;
        }
#undef S2_FETCH
    } SEAM(4);
    if (IN(5)) {
        const int v = F.vcu, s = v & 7, bh = v >> 3;
        if (N_LAUNCHES != 1) { cv_load_g2(F, args); __syncthreads(); }
        for (int i = 0; i < 4; ++i) { const int j = (i == 0) ? s : (i == 1) ? 15 - s : (i == 2) ? 16 + s : 31 - s;
            moba_sweep<3>(F, args, cvI, cv_prev, cv_next, cv_split, bh / NH, bh % NH, j, j * 256 + 32 * F.wave + (lane_id() & 31), true, 0); }
        { LAS unsigned char* scr = F.lds + CV_SCR_OFF + F.wave * CV_SCR_BYTES;
          if (cv_prev < CV_NONE) cv_finish(cvI, scr, lane_id());
          cv_stream(F, args, cv_next, cv_split); }
    } SEAM(5);
    if (IN(6)) {
        pg8::Gemm g{(const bf16*)(ws + WS_AO), (const bf16*)(ws + WS_WO0), MTOK, DM, DM}; pg8::StaticOrder S; S.init(MTOK, DM, F.G, cid);
        pg8::EpiResF32 E{args.in[0], (float*)(ws + WS_H), DM, 1.0f}; pg8::gemm_phase<pg8::EpiResF32, pg8::StaticOrder, false, true>(ring, g, S, E, F.wave);
    } SEAM(6);
    if (IN(7)) { norm_rows_i8(F, (const float*)(ws + WS_H), (unsigned char*)(ws + WS_Y), (float*)(ws + WS_SY), args.in[2]); } SEAM(7);
    if (IN(8)) {
        pg8::Gemm g{(const bf16*)(ws + WS_Y), (const bf16*)(ws + WS_W13D), MTOK, 2 * FFD, DM / 2}; pg8::StaticOrder S; S.init(MTOK, 2 * FFD, F.G, cid);
        float* swp = (float*)(ws + WS_SY) + MTOK;
        if (F.wave == 0 && lane_id() == 0) *swp = __uint_as_float(__hip_atomic_load((const unsigned*)(F.ctl + CW_AMAXW), __ATOMIC_RELAXED, __HIP_MEMORY_SCOPE_AGENT)) * (1.0f / 127.0f);
        __syncthreads();
        pg8::EpiSwiGLUI8 E{(bf16*)(ws + WS_HID), FFD, (const float*)(ws + WS_SY), swp}; pg8::gemm_phase<pg8::EpiSwiGLUI8, pg8::StaticOrder, true, true, false, true>(ring, g, S, E, F.wave);
    } SEAM(8);
    if (IN(9)) {
        pg8::Gemm g{(const bf16*)(ws + WS_HID), (const bf16*)(ws + WS_W2D), MTOK, DM, FFD}; pg8::StaticOrder S; S.init(MTOK, DM, F.G, cid);
        pg8::EpiResF32 E{(const float*)(ws + WS_H), (float*)(ws + WS_H), DM, 1.0f}; pg8::gemm_phase<pg8::EpiResF32, pg8::StaticOrder, false, true>(ring, g, S, E, F.wave);
    } SEAM(9);
    if (IN(10)) { norm_rows(F, (const float*)(ws + WS_H), (bf16*)(ws + WS_Y)); } SEAM(10);
    if (IN(11)) {
        { pg8::Gemm g{(const bf16*)(ws + WS_Y), (const bf16*)(ws + WS_WQK1), MTOK, 4096, DM}; pg8::StaticOrder S; S.init(MTOK, 4096, F.G, cid);
          pg8::EpiBf16 E{(bf16*)(ws + WS_QK), 4096}; pg8::gemm_phase<pg8::EpiBf16, pg8::StaticOrder, false, true>(ring, g, S, E, F.wave); }
        { pg8::Gemm g{(const bf16*)(ws + WS_WV1), (const bf16*)(ws + WS_Y), DM, MTOK, DM}; pg8::StaticOrder S; S.init(DM, MTOK, F.G, cid);
          pg8::EpiBf16 E{(bf16*)(ws + WS_VT), MTOK}; pg8::gemm_phase<pg8::EpiBf16, pg8::StaticOrder, false, true>(ring, g, S, E, F.wave); }
    } SEAM(11);
    if (IN(12)) {
        cv_prev = CV_NONE; cv_next = cv_split + F.vcu * NWAVES + F.wave;
        cv_load_g2(F, args); __syncthreads();
        for (int i = 0; i < 4; ++i) { const int v = F.vcu; if (v >= BATCH * NH * 8) break; sb_unit(F, args, cvI, cv_prev, cv_next, CV_EARLY + CV_LATE, (v >> 3) / NH, (v >> 3) % NH, (v & 7) + 8 * i); }
        { LAS unsigned char* scr = F.lds + CV_SCR_OFF + F.wave * CV_SCR_BYTES;
          if (cv_prev < CV_NONE) cv_finish(cvI, scr, lane_id());
          cv_stream(F, args, cv_next, CV_EARLY + CV_LATE); }
    } SEAM(12);
    if (IN(13)) {
        pg8::Gemm g{(const bf16*)(ws + WS_AO), (const bf16*)(ws + WS_WO1), MTOK, DM, DM}; pg8::StaticOrder S; S.init(MTOK, DM, F.G, cid);
        pg8::EpiResF32 E{(const float*)(ws + WS_H), (float*)(ws + WS_H), DM, 1.0f}; pg8::gemm_phase<pg8::EpiResF32, pg8::StaticOrder, false, true>(ring, g, S, E, F.wave);
    } SEAM(13);
    if (IN(14)) { router_phase(F); } SEAM(14);
    if (IN(15)) { scatter_phase(F); } SEAM(15);
    if (IN(16)) {
        const int* META = (const int*)(ws + WS_META); const int P = __builtin_amdgcn_readfirstlane(META[8]);
        pg8::Gemm g{(const bf16*)(ws + WS_XS), (const bf16*)(ws + WS_W13M), P * 256, 2 * FFE, DM / 2};
        pg8::MoeOrder S; S.so.init(P * 256, 2 * FFE, F.G, cid); S.t1 = __builtin_amdgcn_readfirstlane(META[1]); S.t2 = __builtin_amdgcn_readfirstlane(META[2]); S.t3 = __builtin_amdgcn_readfirstlane(META[3]); S.t4 = __builtin_amdgcn_readfirstlane(META[4]); S.t5 = __builtin_amdgcn_readfirstlane(META[5]); S.t6 = __builtin_amdgcn_readfirstlane(META[6]); S.t7 = __builtin_amdgcn_readfirstlane(META[7]); S.estride = (size_t)2 * FFE * DM;
        pg8::EpiSwiGLU8<FFE> E{(unsigned char*)(ws + WS_HID), 1.0f / (F8_ASCALE * F8_WSCALE), F8_HSCALE}; pg8::gemm_phase<pg8::EpiSwiGLU8<FFE>, pg8::MoeOrder, true, true, true>(ring, g, S, E, F.wave);
    } SEAM(16);
    if (IN(17)) {
        const int* META = (const int*)(ws + WS_META); const int P = __builtin_amdgcn_readfirstlane(META[8]);
        pg8::Gemm g{(const bf16*)(ws + WS_HID), (const bf16*)(ws + WS_W2M), P * 256, DM, FFE / 2};
        pg8::MoeTailOrder<FFE / 128, FFE / 4> S; S.mo.so.init(P * 256, DM, F.G, cid); S.mo.t1 = __builtin_amdgcn_readfirstlane(META[1]); S.mo.t2 = __builtin_amdgcn_readfirstlane(META[2]); S.mo.t3 = __builtin_amdgcn_readfirstlane(META[3]); S.mo.t4 = __builtin_amdgcn_readfirstlane(META[4]); S.mo.t5 = __builtin_amdgcn_readfirstlane(META[5]); S.mo.t6 = __builtin_amdgcn_readfirstlane(META[6]); S.mo.t7 = __builtin_amdgcn_readfirstlane(META[7]); S.mo.estride = (size_t)DM * FFE;
        pg8::EpiScaleBf16Tail<DM> E{(bf16*)(ws + WS_YS), 1.0f / (F8_HSCALE * F8_WSCALE), (float*)(ws + WS_SLAB)}; pg8::gemm_phase<pg8::EpiScaleBf16Tail<DM>, pg8::MoeTailOrder<FFE / 128, FFE / 4>, true, true, true>(ring, g, S, E, F.wave);
    } SEAM(17);
    if (IN(18)) { moe_tail_reduce(args.ws); } SEAM(18);
    if (IN(19)) { combine_phase(F, args.in[16], args.out); }
#ifdef PROBE_T
    GRID_BAR();
    if (PROBE_T_END == NPHASE) PT_STAMP(1);
    GRID_BAR();
    { const unsigned tA = __hip_atomic_load((const unsigned*)((gu32*)(F.ws + WS_CTL) + 8), __ATOMIC_RELAXED, __HIP_MEMORY_SCOPE_AGENT), tB = __hip_atomic_load((const unsigned*)((gu32*)(F.ws + WS_CTL) + 9), __ATOMIC_RELAXED, __HIP_MEMORY_SCOPE_AGENT);
      const float code = (float)((tB - tA + PROBE_T_OFF * 100u) / (100u * PROBE_T_Q));
      for (unsigned i = blockIdx.x * 512u + threadIdx.x; i < (unsigned)MTOK * DM; i += gridDim.x * 512u) args.out[i] = code; }
#endif
#undef IN
#undef SEAM
#undef GRID_BAR
}

extern "C" void kernel_launch(void* const* d_in, const int* in_sizes, int n_in, void* d_out, int out_size, void* d_ws, size_t ws_size, hipStream_t stream) {
    static int grid = 0;
    if (grid == 0) {
        if (n_in != 17 || in_sizes[0] != MTOK * DM || out_size != MTOK * DM || ws_size < WS_END) { fprintf(stderr, "kernel_launch: unexpected shapes (n_in %d, in0 %d, out %d, ws %zu < %zu); nothing launched\n", n_in, n_in > 0 ? in_sizes[0] : -1, out_size, ws_size, (size_t)WS_END); grid = -1; return; }
        int dev = 0, cus = 0, per_cu = 0;
        if (hipGetDevice(&dev) != hipSuccess || hipDeviceGetAttribute(&cus, hipDeviceAttributeMultiprocessorCount, dev) != hipSuccess) { fprintf(stderr, "kernel_launch: device query failed\n"); grid = -1; return; }
        if (hipFuncSetAttribute((const void*)yoco_fwd, hipFuncAttributeMaxDynamicSharedMemorySize, LDS_BYTES) != hipSuccess) { fprintf(stderr, "kernel_launch: hipFuncSetAttribute failed\n"); grid = -1; return; }
        if (hipOccupancyMaxActiveBlocksPerMultiprocessor(&per_cu, (const void*)yoco_fwd, NWAVES * 64, LDS_BYTES) != hipSuccess || per_cu < 1) fprintf(stderr, "kernel_launch: note: occupancy query reports %d workgroups per CU\n", per_cu);
        (void)hipGetLastError();
        grid = cus;
        if (grid != 256) fprintf(stderr, "kernel_launch: %d CUs; this kernel is laid out for 256\n", grid);
    }
    if (grid < 0) return;
    if (hipMemsetAsync((char*)d_ws + WS_CTL, 0, CTL_ZERO_BYTES, stream) != hipSuccess) { fprintf(stderr, "kernel_launch: memset failed\n"); return; }
    Args a{};
    for (int i = 0; i < 17; ++i) a.in[i] = (const float*)d_in[i];
    a.out = (float*)d_out; a.ws = (unsigned char*)d_ws;
    for (int li = 0; li < N_LAUNCHES; ++li) {
#if defined(DBG) && DBG
        if (li == 6 || li == 9 || li == 13) { a.ph_lo = 1000 + (li - 2) + 49; a.ph_hi = a.ph_lo + 1; hipLaunchKernelGGL(yoco_fwd, dim3(grid), dim3(NWAVES * 64), LDS_BYTES, stream, a); }
#endif
        a.ph_lo = (N_LAUNCHES == 1) ? 0 : li; a.ph_hi = (N_LAUNCHES == 1) ? NPHASE : li + 1;
        hipLaunchKernelGGL(yoco_fwd, dim3(grid), dim3(NWAVES * 64), LDS_BYTES, stream, a);
#if defined(DBG) && DBG
        { const int phd = (li < 3) ? li : (li == 5) ? 3 : (li >= 6) ? li - 2 : 900; a.ph_lo = 1000 + phd; a.ph_hi = a.ph_lo + 1; hipLaunchKernelGGL(yoco_fwd, dim3(grid), dim3(NWAVES * 64), LDS_BYTES, stream, a);
          if (li == NPHASE - 1) { a.ph_lo = 1099; a.ph_hi = 1100; hipLaunchKernelGGL(yoco_fwd, dim3(grid), dim3(NWAVES * 64), LDS_BYTES, stream, a); } }
#endif
        const hipError_t le = hipPeekAtLastError();
        if (le != hipSuccess) { fprintf(stderr, "kernel_launch: launch %d failed: %s\n", li, hipGetErrorName(le)); break; }
    }
}
```

```cpp
#include <hip/hip_runtime.h>
#include <cstdio>
#include <cstdint>
__device__ __forceinline__ int lane_id_fresh() { int l; asm volatile("v_mbcnt_lo_u32_b32 %0, -1, 0\n\tv_mbcnt_hi_u32_b32 %0, -1, %0" : "=v"(l)); return l; }
__device__ __forceinline__ int lane_id() { return (int)__builtin_amdgcn_mbcnt_hi(~0u, __builtin_amdgcn_mbcnt_lo(~0u, 0u)); }
namespace pg8 {
#define PG8_LAS __attribute__((address_space(3)))
typedef unsigned short bf16_t;
typedef short bf16x8 __attribute__((ext_vector_type(8)));
typedef float f32x4 __attribute__((ext_vector_type(4)));
typedef unsigned u32x4 __attribute__((ext_vector_type(4)));
constexpr int BM = 256, BK = 64, HALF = 128, HTB = HALF * BK * 2  , STAGE_BYTES = 8 * HTB, NXCD = 8, WGM = 8;

__host__ __device__ __forceinline__ int lds_byte(int r, int c) { const int st = (r >> 4) * 2 + (c >> 5), rr = r & 15, cc = c & 31, ob = rr * 64 + cc * 2; return st * 1024 + (ob ^ (((ob >> 9) & 1) << 5)); }
__host__ __device__ __forceinline__ void stage_rc(int b, int& R, int& C) { const int st = b / 1024, sb = b % 1024, swz = sb ^ (((sb >> 9) & 1) << 5); R = (st >> 1) * 16 + swz / 64; C = (st & 1) * 32 + (swz % 64) / 2; }
__host__ __device__ __forceinline__ int perm32(int rho) { const int n = rho >> 4, i = rho & 15; return 8 * (i >> 2) + 4 * n + (i & 3); }

struct Unit { int pm, pn; size_t boff; int slot; };
struct Gemm { const bf16_t* A; const bf16_t* Bt; int M, N, K; };

struct StaticOrder {
    int nM, nN, nwg, G, c;
    __host__ __device__ void init(int M, int N, int G_, int c_) { nM = M / BM; nN = N / BM; nwg = nM * nN; G = G_; c = c_; }
    static constexpr bool SPLITK = false;
    __host__ __device__ bool next(int i, Unit& u) const { return at((long)i * G + c, u); }
    __host__ __device__ bool at(const long L, Unit& u) const {
        if (L >= nwg) return false;
        int wgid = (int)L; { const int q = nwg / NXCD, r = nwg % NXCD, xcd = wgid % NXCD, off = wgid / NXCD; wgid = (xcd < r ? xcd * (q + 1) : r * (q + 1) + (xcd - r) * q) + off; }
        const int nig = WGM * nN, gid = wgid / nig, fm = gid * WGM, gsz = (nM - fm) < WGM ? (nM - fm) : WGM;
        u.pm = fm + ((wgid % nig) % gsz); u.pn = (wgid % nig) / gsz; u.boff = 0;
#if defined(__HIP_DEVICE_COMPILE__)
        u.pm = __builtin_amdgcn_readfirstlane(u.pm); u.pn = __builtin_amdgcn_readfirstlane(u.pn);
#endif
        return true;
    }
    __device__ __forceinline__ void a_ready(const Unit&) const {}
    __device__ __forceinline__ void done(const Unit&) const {}
};
struct MoeOrder {
    static constexpr bool SPLITK = false;
    StaticOrder so; int t1, t2, t3, t4, t5, t6, t7; size_t estride;
    __device__ bool next(int i, Unit& u) const { return at((long)i * so.G + so.c, u); }
    __device__ bool at(const long L, Unit& u) const {
        if (!so.at(L, u)) return false;
        const int e = __builtin_amdgcn_readfirstlane((u.pm >= t1) + (u.pm >= t2) + (u.pm >= t3) + (u.pm >= t4) + (u.pm >= t5) + (u.pm >= t6) + (u.pm >= t7));
        u.boff = (size_t)e * estride; return true;
    }
    __device__ __forceinline__ void a_ready(const Unit&) const {}
    __device__ __forceinline__ void done(const Unit&) const {}
};
template <int NT_FULL, int KQ_BYTES> struct MoeTailOrder {
    static constexpr bool SPLITK = true;
    MoeOrder mo;
    static __device__ __forceinline__ unsigned koff(const Unit& u) { return u.slot < 0 ? 0u : (unsigned)(u.slot & 3) * (unsigned)KQ_BYTES; }
    static __device__ __forceinline__ int ntile(const Unit& u) { return u.slot < 0 ? NT_FULL : NT_FULL / 4; }
    __device__ bool next(int i, Unit& u) const {
        const int G = mo.so.G, c = mo.so.c, full = mo.so.nwg / G;
        u.slot = -1;
        if (i < full) return mo.at((long)i * G + c, u);
        if (i > full) return false;
        const int tpx = (mo.so.nwg - full * G) / NXCD;
        if (G != 256 || (mo.so.nwg % NXCD) != 0 || tpx > 8) return mo.at((long)i * G + c, u);
        const int x = c % NXCD, j = c / NXCD, tu = j >> 2, ks = j & 3;
        if (tu >= tpx) return false;
        if (!mo.at((long)full * G + tu * NXCD + x, u)) return false;
        u.slot = (x * 8 + tu) * 4 + ks;
#if defined(__HIP_DEVICE_COMPILE__)
        u.slot = __builtin_amdgcn_readfirstlane(u.slot);
#endif
        return true;
    }
    __device__ __forceinline__ void a_ready(const Unit&) const {}
    __device__ __forceinline__ void done(const Unit&) const {}
};

__device__ __forceinline__ unsigned cvt_pk_bf16(float lo, float hi) { unsigned r; asm volatile("v_cvt_pk_bf16_f32 %0, %1, %2" : "=v"(r) : "v"(lo), "v"(hi)); return r; }
typedef int v8i_t __attribute__((ext_vector_type(8)));
typedef int v4i_t __attribute__((ext_vector_type(4)));
__device__ __forceinline__ v8i_t cat8(bf16x8 lo, bf16x8 hi) { const v4i_t a = __builtin_bit_cast(v4i_t, lo), b = __builtin_bit_cast(v4i_t, hi); return __builtin_shufflevector(a, b, 0, 1, 2, 3, 4, 5, 6, 7); }
__device__ __forceinline__ float clamp448(float x) { return __builtin_fminf(__builtin_fmaxf(x, -448.0f), 448.0f); }
__device__ __forceinline__ unsigned pk4_fp8(float a, float b, float c, float d) { int w = 0; w = __builtin_amdgcn_cvt_pk_fp8_f32(clamp448(a), clamp448(b), w, false); w = __builtin_amdgcn_cvt_pk_fp8_f32(clamp448(c), clamp448(d), w, true); return (unsigned)w; }
struct EpiBf16 {
    static constexpr bool PERM = true, AFTER_DRAIN = false;
    bf16_t* O; int ldc;
    __device__ __forceinline__ void operator()(const f32x4 (&acc)[2][2][4][2], const Unit& u, int wr, int wc, int fr, int fq) const {
        const int row0 = u.pm * BM + wr * 64 + fr, col0 = u.pn * BM + wc * 32 + 8 * fq;
#pragma unroll
        for (int ai = 0; ai < 2; ++ai)
#pragma unroll
            for (int m = 0; m < 4; ++m) { bf16_t* rowp = O + (size_t)(row0 + ai * HALF + m * 16) * ldc + col0;
#pragma unroll
                for (int bj = 0; bj < 2; ++bj) { const f32x4 v0 = acc[ai][bj][m][0], v1 = acc[ai][bj][m][1];
                    u32x4 w; w.x = cvt_pk_bf16(v0[0], v0[1]); w.y = cvt_pk_bf16(v0[2], v0[3]); w.z = cvt_pk_bf16(v1[0], v1[1]); w.w = cvt_pk_bf16(v1[2], v1[3]);
                    *(u32x4*)(rowp + bj * HALF) = w; } }
    }
};
struct EpiBf16Kmean {
    static constexpr bool PERM = true, AFTER_DRAIN = false;
    bf16_t* O; int ldc; float* KM;
    __device__ __forceinline__ void operator()(const f32x4 (&acc)[2][2][4][2], const Unit& u, int wr, int wc, int fr, int fq) const {
        const int row0 = u.pm * BM + wr * 64 + fr, col0 = u.pn * BM + wc * 32 + 8 * fq;
#pragma unroll
        for (int ai = 0; ai < 2; ++ai)
#pragma unroll
            for (int m = 0; m < 4; ++m) { bf16_t* rowp = O + (size_t)(row0 + ai * HALF + m * 16) * ldc + col0;
#pragma unroll
                for (int bj = 0; bj < 2; ++bj) { const f32x4 v0 = acc[ai][bj][m][0], v1 = acc[ai][bj][m][1];
                    u32x4 w; w.x = cvt_pk_bf16(v0[0], v0[1]); w.y = cvt_pk_bf16(v0[2], v0[3]); w.z = cvt_pk_bf16(v1[0], v1[1]); w.w = cvt_pk_bf16(v1[2], v1[3]);
                    *(u32x4*)(rowp + bj * HALF) = w; } }
        if (u.pn >= 8) {
#pragma unroll
            for (int bj = 0; bj < 2; ++bj) {
                f32x4 s0 = {0.f, 0.f, 0.f, 0.f}, s1 = s0;
#pragma unroll
                for (int ai = 0; ai < 2; ++ai)
#pragma unroll
                    for (int m = 0; m < 4; ++m) { s0 += acc[ai][bj][m][0]; s1 += acc[ai][bj][m][1]; }
                float cs[8] = {s0[0], s0[1], s0[2], s0[3], s1[0], s1[1], s1[2], s1[3]};
#pragma unroll
                for (int j = 0; j < 8; ++j) {
#pragma unroll
                    for (int o = 1; o < 16; o <<= 1) cs[j] += __shfl_xor(cs[j], o);
                }
                if (fr == 0) { const int col = (u.pn - 8) * BM + bj * HALF + wc * 32 + 8 * fq;
                    float* dst = KM + ((size_t)(((u.pm >> 5) * 16 + (col >> 7)) * 32 + (u.pm & 31)) * 128 + (col & 127));
#pragma unroll
                    for (int j = 0; j < 8; ++j) unsafeAtomicAdd(dst + j, cs[j] * (1.0f / 256.0f)); }
            }
        }
    }
};
struct EpiResF32 {
    static constexpr bool PERM = false, AFTER_DRAIN = false;
    const float* base; float* C; int ldc; float scale;
    __device__ __forceinline__ void operator()(const f32x4 (&acc)[2][2][4][2], const Unit& u, int wr, int wc, int fr, int fq) const {
        const int row0 = u.pm * BM + wr * 64 + fr, col0 = u.pn * BM + wc * 32 + 4 * fq;
#pragma unroll
        for (int ai = 0; ai < 2; ++ai)
#pragma unroll
            for (int m = 0; m < 4; ++m) { const size_t off = (size_t)(row0 + ai * HALF + m * 16) * ldc + col0;
                f32x4 r[2][2];
#pragma unroll
                for (int bj = 0; bj < 2; ++bj)
#pragma unroll
                    for (int n = 0; n < 2; ++n) r[bj][n] = base ? *(const f32x4*)(base + off + bj * HALF + n * 16) : (f32x4){0.f, 0.f, 0.f, 0.f};
#pragma unroll
                for (int bj = 0; bj < 2; ++bj)
#pragma unroll
                    for (int n = 0; n < 2; ++n) *(f32x4*)(C + off + bj * HALF + n * 16) = acc[ai][bj][m][n] * scale + r[bj][n];
                asm volatile("" ::: "memory"); }
    }
};
__device__ __forceinline__ float silu_mul(float g, float u) { const float e = __builtin_amdgcn_exp2f(g * -1.4426950408889634f); return g * __builtin_amdgcn_rcpf(1.0f + e) * u; }
struct EpiSwiGLU {
    static constexpr bool PERM = true, AFTER_DRAIN = false;
    bf16_t* O; int ldc;
    __device__ __forceinline__ void operator()(const f32x4 (&acc)[2][2][4][2], const Unit& u, int wr, int wc, int fr, int fq) const {
        const int row0 = u.pm * BM + wr * 64 + fr, col0 = u.pn * HALF + wc * 32 + 8 * fq;
#pragma unroll
        for (int ai = 0; ai < 2; ++ai)
#pragma unroll
            for (int m = 0; m < 4; ++m) { bf16_t* rowp = O + (size_t)(row0 + ai * HALF + m * 16) * ldc + col0;
                const f32x4 g0 = acc[ai][0][m][0], g1 = acc[ai][0][m][1], u0 = acc[ai][1][m][0], u1 = acc[ai][1][m][1];
                u32x4 w; w.x = cvt_pk_bf16(silu_mul(g0[0], u0[0]), silu_mul(g0[1], u0[1])); w.y = cvt_pk_bf16(silu_mul(g0[2], u0[2]), silu_mul(g0[3], u0[3]));
                w.z = cvt_pk_bf16(silu_mul(g1[0], u1[0]), silu_mul(g1[1], u1[1])); w.w = cvt_pk_bf16(silu_mul(g1[2], u1[2]), silu_mul(g1[3], u1[3]));
                *(u32x4*)rowp = w; }
    }
};
template <int LDC> struct EpiSwiGLU8 {
    static constexpr bool PERM = true, AFTER_DRAIN = false;
    unsigned char* O; float ascale, oscale;
    __device__ __forceinline__ void operator()(const f32x4 (&acc)[2][2][4][2], const Unit& u, int wr, int wc, int fr, int fq) const {
        const unsigned row0 = u.pm * BM + wr * 64 + fr, col0 = u.pn * HALF + wc * 32 + 8 * fq;
        typedef unsigned u32x2 __attribute__((ext_vector_type(2)));
#pragma unroll
        for (int ai = 0; ai < 2; ++ai)
#pragma unroll
            for (int m = 0; m < 4; ++m) { unsigned char* rowp = O + ((row0 + ai * HALF + m * 16) * (unsigned)LDC + col0);
                const f32x4 g0 = acc[ai][0][m][0] * ascale, g1 = acc[ai][0][m][1] * ascale, u0 = acc[ai][1][m][0] * ascale, u1 = acc[ai][1][m][1] * ascale;
                u32x2 w; w.x = pk4_fp8(silu_mul(g0[0], u0[0]) * oscale, silu_mul(g0[1], u0[1]) * oscale, silu_mul(g0[2], u0[2]) * oscale, silu_mul(g0[3], u0[3]) * oscale);
                w.y = pk4_fp8(silu_mul(g1[0], u1[0]) * oscale, silu_mul(g1[1], u1[1]) * oscale, silu_mul(g1[2], u1[2]) * oscale, silu_mul(g1[3], u1[3]) * oscale);
                *(u32x2*)rowp = w; }
    }
};
struct EpiSwiGLUI8 {
    static constexpr bool PERM = true, AFTER_DRAIN = false;
    bf16_t* O; int ldc; const float* sa; const float* sw;
    __device__ __forceinline__ void operator()(const f32x4 (&acc)[2][2][4][2], const Unit& u, int wr, int wc, int fr, int fq) const {
        const int row0 = u.pm * BM + wr * 64 + fr, col0 = u.pn * HALF + wc * 32 + 8 * fq; const float w = *sw;
#pragma unroll
        for (int ai = 0; ai < 2; ++ai)
#pragma unroll
            for (int m = 0; m < 4; ++m) { const int row = row0 + ai * HALF + m * 16; bf16_t* rowp = O + (size_t)row * ldc + col0; const float s = sa[row] * w;
                const v4i_t g0 = __builtin_bit_cast(v4i_t, acc[ai][0][m][0]), g1 = __builtin_bit_cast(v4i_t, acc[ai][0][m][1]), u0 = __builtin_bit_cast(v4i_t, acc[ai][1][m][0]), u1 = __builtin_bit_cast(v4i_t, acc[ai][1][m][1]);
                u32x4 o; o.x = cvt_pk_bf16(silu_mul((float)g0.x * s, (float)u0.x * s), silu_mul((float)g0.y * s, (float)u0.y * s)); o.y = cvt_pk_bf16(silu_mul((float)g0.z * s, (float)u0.z * s), silu_mul((float)g0.w * s, (float)u0.w * s));
                o.z = cvt_pk_bf16(silu_mul((float)g1.x * s, (float)u1.x * s), silu_mul((float)g1.y * s, (float)u1.y * s)); o.w = cvt_pk_bf16(silu_mul((float)g1.z * s, (float)u1.z * s), silu_mul((float)g1.w * s, (float)u1.w * s));
                *(u32x4*)rowp = o; }
    }
};
template <int LDC> struct EpiScaleBf16Tail {
    static constexpr bool PERM = true, AFTER_DRAIN = false;
    bf16_t* O; float scale; float* slab;
    __device__ __forceinline__ void operator()(const f32x4 (&acc)[2][2][4][2], const Unit& u, int wr, int wc, int fr, int fq) const {
        if (u.slot < 0) {
            const unsigned row0 = u.pm * BM + wr * 64 + fr, col0 = u.pn * BM + wc * 32 + 8 * fq;
#pragma unroll
            for (int ai = 0; ai < 2; ++ai)
#pragma unroll
                for (int m = 0; m < 4; ++m) { bf16_t* rowp = O + ((row0 + ai * HALF + m * 16) * (unsigned)LDC + col0);
#pragma unroll
                    for (int bj = 0; bj < 2; ++bj) { const f32x4 v0 = acc[ai][bj][m][0] * scale, v1 = acc[ai][bj][m][1] * scale;
                        u32x4 w; w.x = cvt_pk_bf16(v0[0], v0[1]); w.y = cvt_pk_bf16(v0[2], v0[3]); w.z = cvt_pk_bf16(v1[0], v1[1]); w.w = cvt_pk_bf16(v1[2], v1[3]);
                        *(u32x4*)(rowp + bj * HALF) = w; } }
        } else {
            float* T = slab + (unsigned)u.slot * 65536u; const unsigned row0 = wr * 64 + fr, col0 = wc * 32 + 8 * fq;
#pragma unroll
            for (int ai = 0; ai < 2; ++ai)
#pragma unroll
                for (int m = 0; m < 4; ++m) { float* rowp = T + ((row0 + ai * HALF + m * 16) * 256u + col0);
#pragma unroll
                    for (int bj = 0; bj < 2; ++bj) { *(f32x4*)(rowp + bj * HALF) = acc[ai][bj][m][0] * scale; *(f32x4*)(rowp + bj * HALF + 4) = acc[ai][bj][m][1] * scale; } }
        }
    }
};
template <int LDC> struct EpiScaleBf16 {
    static constexpr bool PERM = true, AFTER_DRAIN = false;
    bf16_t* O; float scale;
    __device__ __forceinline__ void operator()(const f32x4 (&acc)[2][2][4][2], const Unit& u, int wr, int wc, int fr, int fq) const {
        const unsigned row0 = u.pm * BM + wr * 64 + fr, col0 = u.pn * BM + wc * 32 + 8 * fq;
#pragma unroll
        for (int ai = 0; ai < 2; ++ai)
#pragma unroll
            for (int m = 0; m < 4; ++m) { bf16_t* rowp = O + ((row0 + ai * HALF + m * 16) * (unsigned)LDC + col0);
#pragma unroll
                for (int bj = 0; bj < 2; ++bj) { const f32x4 v0 = acc[ai][bj][m][0] * scale, v1 = acc[ai][bj][m][1] * scale;
                    u32x4 w; w.x = cvt_pk_bf16(v0[0], v0[1]); w.y = cvt_pk_bf16(v0[2], v0[3]); w.z = cvt_pk_bf16(v1[0], v1[1]); w.w = cvt_pk_bf16(v1[2], v1[3]);
                    *(u32x4*)(rowp + bj * HALF) = w; } }
    }
};
template <int LDC> struct EpiScaleF32 {
    static constexpr bool PERM = false, AFTER_DRAIN = false;
    float* C; float scale;
    __device__ __forceinline__ void operator()(const f32x4 (&acc)[2][2][4][2], const Unit& u, int wr, int wc, int fr, int fq) const {
        const unsigned row0 = u.pm * BM + wr * 64 + fr, col0 = u.pn * BM + wc * 32 + 4 * fq;
#pragma unroll
        for (int ai = 0; ai < 2; ++ai)
#pragma unroll
            for (int m = 0; m < 4; ++m) { float* rowp = C + ((row0 + ai * HALF + m * 16) * (unsigned)LDC + col0);
#pragma unroll
                for (int bj = 0; bj < 2; ++bj)
#pragma unroll
                    for (int n = 0; n < 2; ++n) *(f32x4*)(rowp + bj * HALF + n * 16) = acc[ai][bj][m][n] * scale; }
    }
};

template <class Epi, class Sched, bool ALIGN_EPI = false, bool SP2 = false, bool F8 = false, bool I8 = false>
__device__ __forceinline__ void gemm_phase(PG8_LAS unsigned char* lds, const Gemm g, const Sched& S, const Epi& E, const int wid) {
    const int lane = lane_id_fresh(), tid = wid * 64 + lane, wr = wid >> 2, wc = wid & 3, fr = lane & 15, fq = lane >> 4;
    const int K = g.K, nt = K / BK;
    unsigned voffA[2], voffB[2];
#pragma unroll
    for (int i = 0; i < 2; ++i) { int R, C; stage_rc(tid * 16 + i * 8192, R, C); const int Rb = Epi::PERM ? ((R & ~31) + perm32(R & 31)) : R;
        voffA[i] = (unsigned)(R * K + C) * 2u; voffB[i] = (unsigned)(Rb * K + C) * 2u; }
    const unsigned kstep = (unsigned)(BK * 2);
    const unsigned hstep = (unsigned)HALF * K * 2;
    const unsigned tstep = 2 * hstep;
    const __amdgpu_buffer_rsrc_t rsA = __builtin_amdgcn_make_buffer_rsrc((void*)g.A, 0, 0xffffffff, 0x00020000), rsB = __builtin_amdgcn_make_buffer_rsrc((void*)g.Bt, 0, 0xffffffff, 0x00020000);
    const unsigned ldsw = (unsigned)wid * 1024u;
    const int aoff = lds_byte(wr * 64 + fr, fq * 8), boff = lds_byte(wc * 32 + fr, fq * 8);
#define PG8_SA(b, h) (((b) * 2 + (h)) * HTB)
#define PG8_SB(b, h) ((4 + (b) * 2 + (h)) * HTB)
#define PG8_STAGE(rs, bufoff, gbase, voff) do { _Pragma("unroll") for (int _i = 0; _i < 2; ++_i) \
        __builtin_amdgcn_raw_ptr_buffer_load_lds(rs, (PG8_LAS unsigned*)(lds + (bufoff) + ldsw + _i * 8192), 16, (int)(voff)[_i], (int)(gbase), 0, 0); } while (0)
#define PG8_LDA(dst, b, h) do { if constexpr (F8) { _Pragma("unroll") for (int m = 0; m < 4; ++m) { dst##8[m].lo = *(const PG8_LAS v4i_t*)(lds + PG8_SA(b, h) + aoff + m * 2048); dst##8[m].hi = *(const PG8_LAS v4i_t*)(lds + PG8_SA(b, h) + aoff + m * 2048 + 1024); } } \
    else { _Pragma("unroll") for (int m = 0; m < 4; ++m) _Pragma("unroll") for (int k = 0; k < 2; ++k) dst[m][k] = *(const PG8_LAS bf16x8*)(lds + PG8_SA(b, h) + aoff + m * 2048 + k * 1024); } } while (0)
#define PG8_LDB(dst, b, h) do { if constexpr (F8) { _Pragma("unroll") for (int n = 0; n < 2; ++n) { dst##8[n].lo = *(const PG8_LAS v4i_t*)(lds + PG8_SB(b, h) + boff + n * 2048); dst##8[n].hi = *(const PG8_LAS v4i_t*)(lds + PG8_SB(b, h) + boff + n * 2048 + 1024); } } \
    else { _Pragma("unroll") for (int n = 0; n < 2; ++n) _Pragma("unroll") for (int k = 0; k < 2; ++k) dst[n][k] = *(const PG8_LAS bf16x8*)(lds + PG8_SB(b, h) + boff + n * 2048 + k * 1024); } } while (0)
#define PG8_MMA(ai, bj, At, Bt) do { __builtin_amdgcn_s_setprio(1); if constexpr (F8) { _Pragma("unroll") for (int m = 0; m < 4; ++m) _Pragma("unroll") for (int n = 0; n < 2; ++n) \
        { if (n == 0) acc8[ai][bj][m].lo = __builtin_amdgcn_mfma_scale_f32_16x16x128_f8f6f4(Bt##8[0], At##8[m], acc8[ai][bj][m].lo, 0, 0, 0, f8scl, 0, f8scl); else acc8[ai][bj][m].hi = __builtin_amdgcn_mfma_scale_f32_16x16x128_f8f6f4(Bt##8[1], At##8[m], acc8[ai][bj][m].hi, 0, 0, 0, f8scl, 0, f8scl); } } \
    else if constexpr (I8) { _Pragma("unroll") for (int m = 0; m < 4; ++m) _Pragma("unroll") for (int n = 0; n < 2; ++n) _Pragma("unroll") for (int k = 0; k < 2; ++k) \
        acc[ai][bj][m][n] = __builtin_bit_cast(f32x4, __builtin_amdgcn_mfma_i32_16x16x64_i8(__builtin_bit_cast(v4i_t, Bt[n][k]), __builtin_bit_cast(v4i_t, At[m][k]), __builtin_bit_cast(v4i_t, acc[ai][bj][m][n]), 0, 0, 0)); } \
    else { _Pragma("unroll") for (int m = 0; m < 4; ++m) _Pragma("unroll") for (int n = 0; n < 2; ++n) _Pragma("unroll") for (int k = 0; k < 2; ++k) \
        acc[ai][bj][m][n] = __builtin_amdgcn_mfma_f32_16x16x32_bf16(Bt[n][k], At[m][k], acc[ai][bj][m][n], 0, 0, 0); } __builtin_amdgcn_s_setprio(0); } while (0)
#define PG8_WAIT_V(n) asm volatile("s_waitcnt vmcnt(" #n ")" ::: "memory")
#define PG8_WAIT_L(n) asm volatile("s_waitcnt lgkmcnt(" #n ")" ::: "memory")
#define PG8_BAR __builtin_amdgcn_s_barrier()
#define PG8_SCHED __builtin_amdgcn_sched_barrier(0)
#define PG8_ZERO8() do { if constexpr (F8) { _Pragma("unroll") for (int a = 0; a < 2; ++a) _Pragma("unroll") for (int b = 0; b < 2; ++b) _Pragma("unroll") for (int m = 0; m < 4; ++m) acc8[a][b][m] = (f32x8_t){0.f, 0.f, 0.f, 0.f, 0.f, 0.f, 0.f, 0.f}; } } while (0)
#define PG8_UNPACK8() do { if constexpr (F8) { _Pragma("unroll") for (int a = 0; a < 2; ++a) _Pragma("unroll") for (int b = 0; b < 2; ++b) _Pragma("unroll") for (int m = 0; m < 4; ++m) { acc[a][b][m][0] = acc8[a][b][m].lo; acc[a][b][m][1] = acc8[a][b][m].hi; } } } while (0)
    Unit cur, nxt; int ui = 0;
    if (!S.next(0, cur)) return;
    f32x4 acc[2][2][4][2];
    bf16x8 At[4][2], B0[2][2], B1[2][2]; v8i_t At8[4], B08[2], B18[2]; typedef float f32x8_t __attribute__((ext_vector_type(8))); f32x8_t acc8[2][2][4];
#pragma unroll
    for (int a = 0; a < 2; ++a)
#pragma unroll
        for (int b = 0; b < 2; ++b)
#pragma unroll
            for (int m = 0; m < 4; ++m)
#pragma unroll
                for (int n = 0; n < 2; ++n) acc[a][b][m][n] = (f32x4){0.f, 0.f, 0.f, 0.f};
    PG8_ZERO8();
    const int f8scl = 0x7f7f7f7f;
    unsigned cA = (unsigned)cur.pm * tstep, cB = (unsigned)cur.boff + (unsigned)cur.pn * tstep;
    if constexpr (Sched::SPLITK) { cA += Sched::koff(cur); cB += Sched::koff(cur); }
    S.a_ready(cur);
    if constexpr (SP2) {
        PG8_STAGE(rsB, PG8_SB(0, 0), cB, voffB); PG8_STAGE(rsB, PG8_SB(0, 1), cB + hstep, voffB); PG8_STAGE(rsA, PG8_SA(0, 0), cA, voffA); PG8_STAGE(rsA, PG8_SA(0, 1), cA + hstep, voffA);
        if (wr == 1) PG8_BAR;
        PG8_WAIT_V(2); PG8_BAR;
        PG8_STAGE(rsB, PG8_SB(1, 0), cB + kstep, voffB); PG8_STAGE(rsA, PG8_SA(1, 0), cA + kstep, voffA); PG8_STAGE(rsB, PG8_SB(1, 1), cB + hstep + kstep, voffB);
        PG8_WAIT_V(6); PG8_BAR;
    } else {
        PG8_STAGE(rsB, PG8_SB(0, 0), cB, voffB); PG8_STAGE(rsA, PG8_SA(0, 0), cA, voffA); PG8_STAGE(rsB, PG8_SB(0, 1), cB + hstep, voffB); PG8_STAGE(rsA, PG8_SA(0, 1), cA + hstep, voffA);
        if (wr == 1) PG8_BAR;
        PG8_WAIT_V(4); PG8_BAR;
        PG8_STAGE(rsB, PG8_SB(1, 0), cB + kstep, voffB); PG8_STAGE(rsA, PG8_SA(1, 0), cA + kstep, voffA); PG8_STAGE(rsB, PG8_SB(1, 1), cB + hstep + kstep, voffB);
        PG8_WAIT_V(6); PG8_BAR;
    }
    for (;;) {
        const bool has_next = S.next(ui + 1, nxt);
        unsigned nA = has_next ? (unsigned)nxt.pm * tstep : cA, nB = has_next ? (unsigned)nxt.boff + (unsigned)nxt.pn * tstep : cB;
        if constexpr (Sched::SPLITK) { if (has_next) { nA += Sched::koff(nxt); nB += Sched::koff(nxt); } }
        int ntc = nt; if constexpr (Sched::SPLITK) ntc = Sched::ntile(cur);
        for (int t = 0; t < ntc; t += 2) {
            const bool last = (t == ntc - 2);
            const unsigned a1 = cA + (unsigned)(t + 1) * kstep;
            const unsigned a2 = last ? nA : cA + (unsigned)(t + 2) * kstep, b2 = last ? nB : cB + (unsigned)(t + 2) * kstep;
            const unsigned a3 = a2 + kstep, b3 = b2 + kstep;
            if (last && has_next) S.a_ready(nxt);
            if constexpr (SP2) {
            PG8_LDB(B0, 0, 0); PG8_LDB(B1, 0, 1); PG8_SCHED; PG8_LDA(At, 0, 0); PG8_STAGE(rsA, PG8_SA(1, 1), a1 + hstep, voffA);
            PG8_WAIT_V(8); PG8_WAIT_L(0); PG8_BAR; PG8_MMA(0, 0, At, B0); PG8_MMA(0, 1, At, B1); PG8_BAR; PG8_SCHED;
            PG8_LDA(At, 0, 1); PG8_STAGE(rsB, PG8_SB(0, 0), b2, voffB); PG8_STAGE(rsB, PG8_SB(0, 1), b2 + hstep, voffB); PG8_STAGE(rsA, PG8_SA(0, 0), a2, voffA);
            PG8_WAIT_V(8); PG8_WAIT_L(0); PG8_BAR; PG8_MMA(1, 0, At, B0); PG8_MMA(1, 1, At, B1); PG8_BAR; PG8_SCHED;
            PG8_LDB(B0, 1, 0); PG8_LDB(B1, 1, 1); PG8_SCHED; PG8_LDA(At, 1, 0); PG8_STAGE(rsA, PG8_SA(0, 1), a2 + hstep, voffA);
            PG8_WAIT_V(8); PG8_WAIT_L(0); PG8_BAR; PG8_MMA(0, 0, At, B0); PG8_MMA(0, 1, At, B1); PG8_BAR; PG8_SCHED;
            PG8_LDA(At, 1, 1); PG8_STAGE(rsB, PG8_SB(1, 0), b3, voffB); PG8_STAGE(rsB, PG8_SB(1, 1), b3 + hstep, voffB); PG8_STAGE(rsA, PG8_SA(1, 0), a3, voffA);
            PG8_WAIT_V(8); PG8_WAIT_L(0); PG8_BAR; PG8_MMA(1, 0, At, B0); PG8_MMA(1, 1, At, B1); PG8_BAR; PG8_SCHED;
            } else {
            PG8_LDB(B0, 0, 0); PG8_SCHED; PG8_LDA(At, 0, 0); PG8_STAGE(rsA, PG8_SA(1, 1), a1 + hstep, voffA);
            PG8_WAIT_L(8); PG8_BAR; PG8_WAIT_L(0); PG8_MMA(0, 0, At, B0); PG8_BAR; PG8_SCHED;
            PG8_LDB(B1, 0, 1); PG8_STAGE(rsB, PG8_SB(0, 0), b2, voffB);
            PG8_BAR; PG8_WAIT_L(0); PG8_MMA(0, 1, At, B1); PG8_BAR;
            PG8_LDA(At, 0, 1); PG8_STAGE(rsA, PG8_SA(0, 0), a2, voffA);
            PG8_BAR; PG8_WAIT_L(0); PG8_MMA(1, 0, At, B0); PG8_BAR; PG8_SCHED;
            PG8_STAGE(rsB, PG8_SB(0, 1), b2 + hstep, voffB);
            PG8_WAIT_V(6); PG8_BAR; PG8_MMA(1, 1, At, B1); PG8_BAR;
            PG8_LDB(B0, 1, 0); PG8_SCHED; PG8_LDA(At, 1, 0); PG8_STAGE(rsA, PG8_SA(0, 1), a2 + hstep, voffA);
            PG8_WAIT_L(8); PG8_BAR; PG8_WAIT_L(0); PG8_MMA(0, 0, At, B0); PG8_BAR; PG8_SCHED;
            PG8_LDB(B1, 1, 1); PG8_STAGE(rsB, PG8_SB(1, 0), b3, voffB);
            PG8_BAR; PG8_WAIT_L(0); PG8_MMA(0, 1, At, B1); PG8_BAR;
            PG8_LDA(At, 1, 1); PG8_STAGE(rsA, PG8_SA(1, 0), a3, voffA);
            PG8_BAR; PG8_WAIT_L(0); PG8_MMA(1, 0, At, B0); PG8_BAR; PG8_SCHED;
            PG8_STAGE(rsB, PG8_SB(1, 1), b3 + hstep, voffB);
            PG8_WAIT_V(6); PG8_BAR; PG8_MMA(1, 1, At, B1); PG8_BAR;
            }
        }
        if constexpr (ALIGN_EPI) { if (wr == 0) PG8_BAR; }
        PG8_UNPACK8();
        if constexpr (!Epi::AFTER_DRAIN) { const int le = lane_id_fresh(); E(acc, cur, wr, wc, le & 15, le >> 4); S.done(cur); }
        if (!has_next) break;
#pragma unroll
        for (int a = 0; a < 2; ++a)
#pragma unroll
            for (int b = 0; b < 2; ++b)
#pragma unroll
                for (int m = 0; m < 4; ++m)
#pragma unroll
                    for (int n = 0; n < 2; ++n) acc[a][b][m][n] = (f32x4){0.f, 0.f, 0.f, 0.f};
        PG8_ZERO8();
        cur = nxt; cA = nA; cB = nB; ++ui;
        if constexpr (ALIGN_EPI) { if (wr == 1) PG8_BAR; }
    }
    PG8_WAIT_V(0);
    if constexpr (!ALIGN_EPI) { if (wr == 0) PG8_BAR; }
    PG8_BAR;
    if constexpr (Epi::AFTER_DRAIN) { E.fused(acc, cur, wr, wc, fr, fq, lds, wid, lane); S.done(cur); }
#undef PG8_SA
#undef PG8_SB
#undef PG8_STAGE
#undef PG8_LDA
#undef PG8_LDB
#undef PG8_MMA
#undef PG8_WAIT_V
#undef PG8_WAIT_L
#undef PG8_BAR
#undef PG8_SCHED
#undef PG8_ZERO8
#undef PG8_UNPACK8
}
}

constexpr int BATCH = 2, SEQ = 8192, DM = 2048, MTOK = BATCH * SEQ, NH = 16, HD = 128, FFD = 5632, NE = 8, FFE = 7168, NBLK = SEQ / 256;
constexpr float RMS_EPS = 1e-6f;
constexpr int NWAVES = 8;
constexpr float F8_WSCALE = 64.0f, F8_ASCALE = 16.0f, F8_HSCALE = 8.0f;
constexpr int NPHASE = 20;
#ifndef MK_N_LAUNCHES
#define MK_N_LAUNCHES 1
#endif
constexpr int N_LAUNCHES = MK_N_LAUNCHES;
static_assert(N_LAUNCHES == 1 || N_LAUNCHES == NPHASE, "MK_N_LAUNCHES is 1 or NPHASE");

constexpr size_t MiB = 1u << 20, KiB = 1u << 10;
constexpr size_t WS_CTL = 0, CTL_ZERO_BYTES = 768 * KiB;
constexpr size_t WS_KMEAN = 256 * KiB;
constexpr size_t WS_KNORM = 2 * MiB + 256 * KiB;
constexpr size_t WS_SY = 2 * MiB + 320 * KiB;
constexpr size_t WS_WRG = 1 * MiB + 512 * KiB;
constexpr size_t WS_TOKE = 1 * MiB + 640 * KiB;
constexpr size_t WS_TOKG = 1 * MiB + 768 * KiB;
constexpr size_t WS_TOKR = 1 * MiB + 896 * KiB;
constexpr size_t WS_TOKP = 2 * MiB;
constexpr size_t WS_CNT = 2 * MiB + 128 * KiB;
constexpr size_t WS_META = 2 * MiB + 192 * KiB;
constexpr size_t WS_WQK0 = 4 * MiB, WS_WV0 = 20 * MiB, WS_WO0 = 28 * MiB, WS_W13D = 36 * MiB, WS_W2D = 80 * MiB;
constexpr size_t WS_WQK1 = 102 * MiB, WS_WV1 = 118 * MiB, WS_WO1 = 126 * MiB, WS_W13M = 134 * MiB, WS_W2M = 582 * MiB;
constexpr size_t WS_H = 806 * MiB;
constexpr size_t WS_Y = 934 * MiB;
constexpr size_t WS_QK = 998 * MiB, WS_VT = 1126 * MiB, WS_AO = 1190 * MiB;
constexpr size_t WS_XS = 998 * MiB, WS_YS = 998 * MiB;
constexpr size_t WS_SLAB = 1192 * MiB;
constexpr size_t WS_LIST = 1270 * MiB;
constexpr size_t WS_PB = 1286 * MiB;
constexpr size_t WS_HID = 1270 * MiB;
constexpr size_t WS_END = 1746 * MiB;
constexpr int MOE_ROWS = 34816;
constexpr int CW_TMO = 0, CW_CODE = 1, CW_BAR = 4096, CW_AMAXW = 16;

constexpr int LDS_BYTES = 147456;
constexpr int MISC_OFF = LDS_BYTES - 256;
constexpr int RING_BYTES = 131072;

#define GAS __attribute__((address_space(1)))
#define LAS __attribute__((address_space(3)))
typedef unsigned short bf16;
typedef unsigned v4u __attribute__((ext_vector_type(4)));
typedef float f32x4 __attribute__((ext_vector_type(4)));
typedef short bf16x8 __attribute__((ext_vector_type(8)));
typedef GAS unsigned gu32;
typedef GAS unsigned long long gu64;
#define RLX_AGENT __ATOMIC_RELAXED, __HIP_MEMORY_SCOPE_AGENT
#define LDS_WAIT() asm volatile("s_waitcnt lgkmcnt(0)" ::: "memory")
#define VM_WAIT() asm volatile("s_waitcnt vmcnt(0)" ::: "memory")
__device__ __forceinline__ unsigned long long rt() { return __builtin_amdgcn_s_memrealtime(); }
__device__ __forceinline__ unsigned f2bf(float f) { unsigned u = __builtin_bit_cast(unsigned, f); return (u + 0x7fffu + ((u >> 16) & 1u)) >> 16; }
__device__ __forceinline__ unsigned pk2(float lo, float hi) { return f2bf(lo) | (f2bf(hi) << 16); }

#define XB_TMO      128
#define XB_XCNT(j)  (256  + 64 * (j))
#define XB_XSUB(j)  (1280 + 64 * (j))
#define XB_XGEN(j)  (2304 + 64 * (j))
#define XB_TOP      3328
#define XB_TOPGEN   3392
#define XCD_BAR_WORDS 3456
#define XB_SPIN_CAP (1u << 18)

__device__ __forceinline__ unsigned xb_ld(unsigned* p)              { return __hip_atomic_load(p, __ATOMIC_RELAXED, __HIP_MEMORY_SCOPE_AGENT); }
__device__ __forceinline__ unsigned xb_add(unsigned* p, unsigned v) { return __hip_atomic_fetch_add(p, v, __ATOMIC_RELAXED, __HIP_MEMORY_SCOPE_AGENT); }
__device__ __forceinline__ unsigned xb_xcc_id() { return (unsigned)__builtin_amdgcn_s_getreg((3 << 11) | 20) & 0xFu; }
#define XB_SPIN(cond, bar) do { unsigned _sp = 0; while (cond) { __builtin_amdgcn_s_sleep(1); \
    if ((++_sp & 255u) == 0u) { if (xb_ld(&(bar)[XB_TMO])) break; if (_sp > XB_SPIN_CAP) { atomicAdd(&(bar)[XB_TMO], 1u); break; } } } } while (0)

struct XcdBarrier {
    unsigned* bar; unsigned x;
    int wave;
    volatile LAS unsigned* st;
};

__device__ __forceinline__ XcdBarrier xcd_barrier_post(unsigned* bar, volatile LAS unsigned* st, int wave) {
    XcdBarrier b; b.bar = bar; b.x = xb_xcc_id(); b.st = st; b.wave = wave;
    if (wave == 0 && lane_id() == 0) (void)xb_add(&bar[XB_XCNT(b.x)], 1u);
    return b;
}
__device__ __forceinline__ void xcd_barrier_complete(unsigned* bar, unsigned x, unsigned& nloc, unsigned& nx) {
    const unsigned G = gridDim.x * gridDim.y * gridDim.z;
    unsigned sum, cnt, mine, sp = 0u;
    for (;;) {
        sum = 0u; cnt = 0u; mine = 0u;
#pragma unroll
        for (unsigned j = 0; j < 16; ++j) { const unsigned c = xb_ld(&bar[XB_XCNT(j)]); sum += c; cnt += (c > 0u) ? 1u : 0u; mine = (j == x) ? c : mine; }
        if (sum == G) break;
        __builtin_amdgcn_s_sleep(1);
        if ((++sp & 255u) == 0u) { if (xb_ld(&bar[XB_TMO])) break; if (sp > XB_SPIN_CAP) { atomicAdd(&bar[XB_TMO], 1u); break; } }
    }
    nloc = mine > 0u ? mine : 1u; nx = cnt > 0u ? cnt : 1u;
}

__device__ __forceinline__ void xcd_barrier(const XcdBarrier& b) {
    asm volatile("s_waitcnt vmcnt(0)" ::: "memory");
    __syncthreads();
    if (b.wave == 0 && lane_id() == 0) {
        unsigned* bar = b.bar;
        __builtin_amdgcn_s_waitcnt(0);
        unsigned nloc = b.st[0], nx = b.st[1];
        if (nloc == 0u) { xcd_barrier_complete(bar, b.x, nloc, nx); b.st[0] = nloc; b.st[1] = nx; }
        const unsigned old = xb_add(&bar[XB_XSUB(b.x)], 1u);
        const unsigned gen = old / nloc;
        if (old + 1u == (gen + 1u) * nloc) {
            __builtin_amdgcn_fence(__ATOMIC_RELEASE, "agent");
            asm volatile("s_waitcnt vmcnt(0)" ::: "memory");
            const unsigned og = xb_add(&bar[XB_TOP], 1u);
            const unsigned tg = og / nx;
            if (og + 1u == (tg + 1u) * nx) xb_add(&bar[XB_TOPGEN], 1u);
            else XB_SPIN(xb_ld(&bar[XB_TOPGEN]) == tg, bar);
            __builtin_amdgcn_fence(__ATOMIC_ACQUIRE, "agent");
            xb_add(&bar[XB_XGEN(b.x)], 1u);
            asm volatile("s_waitcnt vmcnt(0)" ::: "memory");
        } else {
            XB_SPIN(xb_ld(&bar[XB_XGEN(b.x)]) == gen, bar);
            __builtin_amdgcn_fence(__ATOMIC_ACQUIRE, "agent");
            asm volatile("s_waitcnt vmcnt(0)" ::: "memory");
        }
    }
    __syncthreads();
}

typedef float f32x16 __attribute__((ext_vector_type(16)));
typedef float f32x2v __attribute__((ext_vector_type(2)));
typedef __bf16 bf16x2v __attribute__((ext_vector_type(2)));
typedef short s16x4 __attribute__((ext_vector_type(4)));
struct Frame {
    LAS unsigned char* lds;
    volatile LAS unsigned* MISC;
    gu32* ctl;
    int wave;
    int vcu, G;
    unsigned char* ws;
};
struct Args { const float* in[17]; float* out; unsigned char* ws; int ph_lo, ph_hi; };
__device__ __forceinline__ float wave_sum(float v) {
#pragma unroll
    for (int o = 1; o < 64; o <<= 1) v += __shfl_xor(v, o);
    return v;
}
__device__ __forceinline__ float wave_sum_l(float v, int lane) {
#pragma unroll
    for (int o = 1; o < 64; o <<= 1) v += __builtin_bit_cast(float, __builtin_amdgcn_ds_bpermute((lane ^ o) << 2, __builtin_bit_cast(int, v)));
    return v;
}
__device__ __forceinline__ unsigned cvtpk(float lo, float hi) { f32x2v v = {lo, hi}; bf16x2v b = __builtin_convertvector(v, bf16x2v); return __builtin_bit_cast(unsigned, b); }
__device__ __forceinline__ float bf2f(unsigned short b) { return __builtin_bit_cast(float, (unsigned)b << 16); }
__device__ __forceinline__ float swap_lo(float x, float& hi_out) { const unsigned xu = __float_as_uint(x); auto rr = __builtin_amdgcn_permlane32_swap(xu, xu, false, false); const unsigned r0 = rr[0], r1 = rr[1]; hi_out = __uint_as_float(r1); return __uint_as_float(r0); }

constexpr int CV_QK0 = 32 * 128, CV_O = 32 * 64, CV_D13 = 32 * 176, CV_D2 = 88 * 64, CV_M13 = 32 * 224, CV_M2 = 112 * 64;
constexpr int CV_EARLY = CV_QK0 + CV_O;
constexpr int CV_LATE = CV_O + 2 * CV_D13 + CV_D2 + 4 * CV_O + 8 * (2 * CV_M13 + CV_M2);
constexpr int CV_NONMOE = CV_LATE - 8 * (2 * CV_M13 + CV_M2);
constexpr int CV_SCR_OFF = 69632, CV_SCR_BYTES = 8192;
constexpr int CV_SPLIT_PER_WAVE = 68;
constexpr int CV_NONE = 1 << 28;
struct CvItem { __amdgpu_buffer_rsrc_t rs; int soff, ld; bf16* WT; int dK; const float* g; int f8, k0, drow0; float qs; const unsigned* amax; int glds; };
__device__ __forceinline__ void cv_decode(const Args& A, unsigned char* ws, int r, CvItem& I, const bool live = true) {
    r = __builtin_amdgcn_readfirstlane(r);
    I.glds = 0;
    bool hit = false; int wi = 0, wo = 0, ld = 0, K = 0, gi = -1, go = 0, mode = 0, sel = 0, roff = 0, f8 = 0, kb = 0, nn = 0; size_t dst = 0, woff = 0;
    if (r >= CV_EARLY + CV_NONMOE) {
        int q = r - (CV_EARLY + CV_NONMOE); hit = true; f8 = 1; I.glds = (q < 16 * CV_M13) ? 1 : 0;
        if (q < 16 * CV_M13) { sel = (q >= 8 * CV_M13) ? 1 : 0; q -= sel * 8 * CV_M13; const int e = q / CV_M13; q -= e * CV_M13; wi = 13 + sel; woff = (size_t)e * DM * FFE; ld = FFE; K = DM; dst = WS_W13M + (size_t)e * 2 * FFE * DM; gi = 2; go = DM; mode = 1; kb = q / (FFE / 32); nn = q % (FFE / 32); }
        else { q -= 16 * CV_M13; const int e = q / CV_M2; q -= e * CV_M2; wi = 15; woff = (size_t)e * FFE * DM; ld = DM; K = FFE; dst = WS_W2M + (size_t)e * DM * FFE; kb = q / (DM / 32); nn = q % (DM / 32); }
    }
#define JOB(cnt, wi_, wo_, ld_, K_, N_, dst_, gi_, go_, mode_, sel_, roff_) if (!hit) { if (r < (cnt)) { wi = (wi_); wo = (wo_); ld = (ld_); K = (K_); dst = (dst_); gi = (gi_); go = (go_); mode = (mode_); sel = (sel_); roff = (roff_); kb = r / ((N_) / 32); nn = r % ((N_) / 32); hit = true; } else r -= (cnt); }
    JOB(CV_QK0, 3, 0, 6144, DM, 4096, WS_WQK0, 1, 0, 0, 0, 0)
    JOB(CV_O, 3, 4096, 6144, DM, 2048, WS_WV0, 1, 0, 0, 0, 0)
    JOB(CV_O, 4, 0, 2048, DM, 2048, WS_WO0, -1, 0, 0, 0, 0)
    JOB(CV_D13, 9, 0, FFD, DM, FFD, WS_W13D, -1, 0, 1, 0, 0) if (hit && wi == 9) f8 = 2;
    JOB(CV_D13, 10, 0, FFD, DM, FFD, WS_W13D, -1, 0, 1, 1, 0) if (hit && wi == 10) f8 = 2;
    JOB(CV_D2, 11, 0, DM, FFD, DM, WS_W2D, -1, 0, 0, 0, 0)
    JOB(CV_O, 7, 0, 2048, DM, 2048, WS_WQK1, 1, DM, 0, 0, 0)
    JOB(CV_O, 6, 0, 4096, DM, 2048, WS_WQK1, 5, 0, 0, 0, 2048)
    JOB(CV_O, 6, 2048, 4096, DM, 2048, WS_WV1, 5, 0, 0, 0, 0)
    JOB(CV_O, 8, 0, 2048, DM, 2048, WS_WO1, -1, 0, 0, 0, 0)
    if (!hit) { if (r < 8 * CV_M13) { const int e = r / CV_M13; r -= e * CV_M13; wi = 13; woff = (size_t)e * DM * FFE; ld = FFE; K = DM; dst = WS_W13M + (size_t)e * 2 * FFE * DM; gi = 2; go = DM; mode = 1; sel = 0; f8 = 1; kb = r / (FFE / 32); nn = r % (FFE / 32); hit = true; } else r -= 8 * CV_M13; }
    if (!hit) { if (r < 8 * CV_M13) { const int e = r / CV_M13; r -= e * CV_M13; wi = 14; woff = (size_t)e * DM * FFE; ld = FFE; K = DM; dst = WS_W13M + (size_t)e * 2 * FFE * DM; gi = 2; go = DM; mode = 1; sel = 1; f8 = 1; kb = r / (FFE / 32); nn = r % (FFE / 32); hit = true; } else r -= 8 * CV_M13; }
    if (!hit) { const int e = r / CV_M2; r -= e * CV_M2; wi = 15; woff = (size_t)e * FFE * DM; ld = DM; K = FFE; dst = WS_W2M + (size_t)e * DM * FFE; f8 = 1; kb = r / (DM / 32); nn = r % (DM / 32); hit = true; }
#undef JOB
    const int k0 = kb * 64, n0 = nn * 32;
    I.rs = __builtin_amdgcn_make_buffer_rsrc((void*)(A.in[wi] + woff + wo), 0, __builtin_amdgcn_readfirstlane(live ? -1 : 0), 0x00020000); I.soff = (k0 * ld + n0) * 4; I.ld = ld;
    I.WT = (bf16*)(ws + dst); I.dK = K; I.g = (gi >= 0) ? A.in[gi] + go : nullptr; I.f8 = f8; I.k0 = k0;
    I.qs = (f8 == 1) ? F8_WSCALE : 1.0f; I.amax = (const unsigned*)(ws + WS_CTL) + CW_AMAXW;
    I.drow0 = mode ? (n0 / 128) * 256 + sel * 128 + (n0 % 128) : roff + n0;
}
__device__ __forceinline__ void cv_issue(const CvItem& I, LAS unsigned char* scr, int lane) {
    int lv = lane; asm volatile("" : "+v"(lv));
    const int rowoff = (lv >> 3) * I.ld * 4, p = lv & 7;
#pragma unroll
    for (int q = 0; q < 8; ++q) __builtin_amdgcn_raw_ptr_buffer_load_lds(I.rs, (LAS unsigned*)(scr + q * 1024), 16, rowoff + ((p ^ q) << 4), I.soff + q * 8 * I.ld * 4, 0, 2);
}
__device__ __forceinline__ void cv_gload(const CvItem& I, int lane, f32x4& ga, f32x4& gb, const LAS float* g2 = nullptr, const bool use_g2 = false) {
    const int c = lane & 7; ga = (f32x4){1.f, 1.f, 1.f, 1.f}; gb = ga;
    if (use_g2 && I.glds) { ga = *(const LAS f32x4*)(g2 + I.k0 + 8 * c); gb = *(const LAS f32x4*)(g2 + I.k0 + 8 * c + 4); }
    else if (I.g) { ga = *(const GAS f32x4*)(I.g + I.k0 + 8 * c); gb = *(const GAS f32x4*)(I.g + I.k0 + 8 * c + 4); }
    float qs = I.qs; if (I.f8 == 2) qs = 127.0f / fmaxf(__uint_as_float(__hip_atomic_load(I.amax, __ATOMIC_RELAXED, __HIP_MEMORY_SCOPE_AGENT)), 1e-30f);
    ga = ga * qs; gb = gb * qs;
}
template <int WAITN> __device__ __forceinline__ void cv_finish_g(const CvItem& I, const LAS unsigned char* scrb, int lane, f32x4 ga, f32x4 gb) {
    if (WAITN == 8) asm volatile("s_waitcnt vmcnt(8)" ::: "memory"); else asm volatile("s_waitcnt vmcnt(0)" ::: "memory");
    const LAS float* scr = (const LAS float*)scrb;
    const int c = lane & 7, nn = lane >> 3;
    int lbase = c * 256 + 8 * (c >> 1) + 4 * ((nn >> 2) ^ (c & 1)) + (nn & 3); asm volatile("" : "+v"(lbase));
#pragma unroll
    for (int jj = 0; jj < 4; ++jj) { const int n = nn + 8 * jj; float x[8]; const LAS float* bp = scr + (lbase ^ (8 * jj));
#pragma unroll
        for (int i = 0; i < 8; ++i) x[i] = bp[32 * i];
        if (I.f8 == 2) { typedef unsigned v2u __attribute__((ext_vector_type(2)));
            const int q0 = (int)rintf(x[0] * ga.x), q1 = (int)rintf(x[1] * ga.y), q2 = (int)rintf(x[2] * ga.z), q3 = (int)rintf(x[3] * ga.w), q4 = (int)rintf(x[4] * gb.x), q5 = (int)rintf(x[5] * gb.y), q6 = (int)rintf(x[6] * gb.z), q7 = (int)rintf(x[7] * gb.w);
            v2u o; o.x = (unsigned)(q0 & 0xff) | ((unsigned)(q1 & 0xff) << 8) | ((unsigned)(q2 & 0xff) << 16) | ((unsigned)q3 << 24); o.y = (unsigned)(q4 & 0xff) | ((unsigned)(q5 & 0xff) << 8) | ((unsigned)(q6 & 0xff) << 16) | ((unsigned)q7 << 24);
            __builtin_nontemporal_store(o, (GAS v2u*)((unsigned char*)I.WT + (size_t)(I.drow0 + n) * I.dK + I.k0 + 8 * c)); }
        else if (I.f8) { typedef unsigned v2u __attribute__((ext_vector_type(2)));
            v2u o; o.x = pg8::pk4_fp8(x[0] * ga.x, x[1] * ga.y, x[2] * ga.z, x[3] * ga.w); o.y = pg8::pk4_fp8(x[4] * gb.x, x[5] * gb.y, x[6] * gb.z, x[7] * gb.w);
            __builtin_nontemporal_store(o, (GAS v2u*)((unsigned char*)I.WT + (size_t)(I.drow0 + n) * I.dK + I.k0 + 8 * c)); }
        else { v4u o; o.x = pk2(x[0] * ga.x, x[1] * ga.y); o.y = pk2(x[2] * ga.z, x[3] * ga.w); o.z = pk2(x[4] * gb.x, x[5] * gb.y); o.w = pk2(x[6] * gb.z, x[7] * gb.w);
            __builtin_nontemporal_store(o, (GAS v4u*)(I.WT + (size_t)(I.drow0 + n) * I.dK + I.k0 + 8 * c)); } }
    LDS_WAIT(); asm volatile("" ::: "memory");
}
__device__ __forceinline__ void cv_finish(const CvItem& I, const LAS unsigned char* scrb, int lane, const LAS float* g2 = nullptr, const bool use_g2 = false) {
    asm volatile("s_waitcnt vmcnt(0)" ::: "memory");
    f32x4 ga, gb; cv_gload(I, lane, ga, gb, g2, use_g2); cv_finish_g<0>(I, scrb, lane, ga, gb);
}
constexpr int CV_G2_OFF = 137728;
__device__ __forceinline__ void cv_load_g2(Frame& F, const Args& A) { const int t = F.wave * 64 + lane_id(); *(LAS f32x4*)(F.lds + CV_G2_OFF + t * 16) = *(const GAS f32x4*)(A.in[2] + DM + t * 4); }
__device__ __forceinline__ void cv_stream(Frame& F, const Args& A, int first, const int lim) {
    const int step = F.G * NWAVES; unsigned char* ws = F.ws;
    LAS unsigned char* sA = F.lds + CV_SCR_OFF + F.wave * CV_SCR_BYTES; LAS unsigned char* sB = F.lds + F.wave * CV_SCR_BYTES;
    int cur = first; int par = 0;
    if (cur < lim) { CvItem I; cv_decode(A, ws, cur, I); cv_issue(I, sA, lane_id()); }
    while (cur < lim) {
        const int nxt = cur + step; LAS unsigned char* sc = par ? sB : sA; LAS unsigned char* sn = par ? sA : sB;
        CvItem I; cv_decode(A, ws, cur, I); f32x4 ga, gb; cv_gload(I, lane_id(), ga, gb);
        if (nxt < lim) { CvItem J; cv_decode(A, ws, nxt, J); cv_issue(J, sn, lane_id()); cv_finish_g<8>(I, sc, lane_id(), ga, gb); }
        else cv_finish_g<0>(I, sc, lane_id(), ga, gb);
        cur = nxt; par ^= 1;
    }
}
__device__ __forceinline__ void norm_rows(Frame& F, const float* src, bf16* dst) {
    const int gw = F.vcu * NWAVES + F.wave, NGW = F.G * NWAVES;
    for (int m = gw; m < MTOK; m += NGW) {
        const GAS f32x4* xr = (const GAS f32x4*)(src + (size_t)m * DM) + lane_id();
        f32x4 v[8]; float s = 0.f;
#pragma unroll
        for (int j = 0; j < 8; ++j) { v[j] = xr[64 * j]; s += (v[j].x * v[j].x + v[j].y * v[j].y) + (v[j].z * v[j].z + v[j].w * v[j].w); }
        const float r = 1.0f / sqrtf(wave_sum(s) * (1.0f / DM) + RMS_EPS);
        GAS unsigned long long* o8 = (GAS unsigned long long*)(dst + (size_t)m * DM) + lane_id();
#pragma unroll
        for (int j = 0; j < 8; ++j) o8[64 * j] = (unsigned long long)cvtpk(v[j].x * r, v[j].y * r) | ((unsigned long long)cvtpk(v[j].z * r, v[j].w * r) << 32);
    }
}
__device__ __forceinline__ void norm_rows_i8(Frame& F, const float* src, unsigned char* dst, float* srow, const float* g) {
    const int gw = F.vcu * NWAVES + F.wave, NGW = F.G * NWAVES;
    for (int m = gw; m < MTOK; m += NGW) {
        const GAS f32x4* xr = (const GAS f32x4*)(src + (size_t)m * DM) + lane_id(); const GAS f32x4* gr = (const GAS f32x4*)g + lane_id();
        f32x4 v[8]; float s = 0.f;
#pragma unroll
        for (int j = 0; j < 8; ++j) { v[j] = xr[64 * j]; s += (v[j].x * v[j].x + v[j].y * v[j].y) + (v[j].z * v[j].z + v[j].w * v[j].w); }
        const float r = 1.0f / sqrtf(wave_sum(s) * (1.0f / DM) + RMS_EPS); float mx = 0.f;
#pragma unroll
        for (int j = 0; j < 8; ++j) { v[j] = v[j] * r * gr[64 * j]; mx = fmaxf(fmaxf(mx, fmaxf(fabsf(v[j].x), fabsf(v[j].y))), fmaxf(fabsf(v[j].z), fabsf(v[j].w))); }
#pragma unroll
        for (int o = 1; o < 64; o <<= 1) mx = fmaxf(mx, __shfl_xor(mx, o));
        mx = fmaxf(mx, 1e-20f); const float qs = 127.0f / mx;
        GAS unsigned* o4 = (GAS unsigned*)(dst + (size_t)m * DM) + lane_id();
#pragma unroll
        for (int j = 0; j < 8; ++j) { const int a0 = (int)rintf(v[j].x * qs), a1 = (int)rintf(v[j].y * qs), a2 = (int)rintf(v[j].z * qs), a3 = (int)rintf(v[j].w * qs);
            o4[64 * j] = (unsigned)(a0 & 0xff) | ((unsigned)(a1 & 0xff) << 8) | ((unsigned)(a2 & 0xff) << 16) | ((unsigned)a3 << 24); }
        if (lane_id() == 0) srow[m] = mx * (1.0f / 127.0f);
    }
}
__device__ __forceinline__ void p0_prologue(Frame& F, const Args& A) {
    LAS unsigned char* scr = F.lds + CV_SCR_OFF + F.wave * CV_SCR_BYTES;
    const int gw = F.vcu * NWAVES + F.wave, NGW = F.G * NWAVES;
    unsigned char* ws = F.ws;
    cv_stream(F, A, gw, CV_EARLY);
    { const int gt = F.vcu * NWAVES * 64 + (F.wave * 64 + lane_id()); if (gt < DM * NE) { const int k = gt / NE, e = gt % NE; ((float*)(ws + WS_WRG))[e * DM + k] = A.in[2][DM + k] * A.in[12][gt]; } }
    norm_rows(F, A.in[0], (bf16*)(ws + WS_Y));
    { float mx = 0.f; const size_t n4 = (size_t)DM * FFD / 4; const size_t tid0 = (size_t)(F.vcu * NWAVES + F.wave) * 64 + lane_id(), nth = (size_t)F.G * NWAVES * 64;
      for (size_t i = tid0; i < 2 * n4; i += nth) { const f32x4 v = (i < n4) ? ((const GAS f32x4*)A.in[9])[i] : ((const GAS f32x4*)A.in[10])[i - n4]; mx = fmaxf(fmaxf(mx, fmaxf(fabsf(v.x), fabsf(v.y))), fmaxf(fabsf(v.z), fabsf(v.w))); }
#pragma unroll
      for (int o = 1; o < 64; o <<= 1) mx = fmaxf(mx, __shfl_xor(mx, o));
      if (lane_id() == 0) atomicMax((unsigned*)(F.ctl + CW_AMAXW), __float_as_uint(mx)); }
}

__device__ __forceinline__ void kmean_phase(Frame& F) {
    const bf16* QK = (const bf16*)(F.ws + WS_QK); float* KM = (float*)(F.ws + WS_KMEAN);
    LAS float* part = (LAS float*)F.lds;
    for (int i = 0; i < 4; ++i) {
        const int item = F.vcu + F.G * i; if (item >= BATCH * NH * NBLK) break;
        const int b = item / (NH * NBLK), h = (item / NBLK) % NH, n = item % NBLK;
        const bf16* kp = QK + ((size_t)(b * SEQ + n * 256 + F.wave * 32)) * 4096 + 2048 + h * HD + 2 * lane_id();
        float s0 = 0.f, s1 = 0.f; unsigned kv[32];
#pragma unroll
        for (int r = 0; r < 32; ++r) kv[r] = *(const GAS unsigned*)(kp + (size_t)r * 4096);
#pragma unroll
        for (int r = 0; r < 32; ++r) { s0 += __uint_as_float(kv[r] << 16); s1 += __uint_as_float(kv[r] & 0xffff0000u); }
        part[F.wave * 128 + 2 * lane_id()] = s0; part[F.wave * 128 + 2 * lane_id() + 1] = s1;
        __syncthreads();
        if ((F.wave * 64 + lane_id()) < 128) { float s = 0.f;
#pragma unroll
            for (int w = 0; w < 8; ++w) s += part[w * 128 + (F.wave * 64 + lane_id())];
            KM[(size_t)item * HD + (F.wave * 64 + lane_id())] = s * (1.0f / 256.0f); }
        __syncthreads();
    }
}

constexpr int ATT_KB = 16384, ATT_VB = 128 * 136, ATT_K0 = 0, ATT_V0 = 2 * ATT_KB, ATT_FLAGS = ATT_V0 + 2 * ATT_VB;
__device__ __forceinline__ int kswz(int row, int colB) { return row * 256 + (colB ^ ((row & 15) << 4)); }
#define LDS_BARRIER() asm volatile("s_waitcnt lgkmcnt(0)\n\ts_barrier" ::: "memory")
struct TileRegs { v4u k0, k1, v0, v1; };
__device__ __forceinline__ void tile_load(TileRegs& T, const bf16* Kb, const bf16* Vtb, int kb, int tid) {
    const int key0 = tid >> 4, c16 = tid & 15, d0 = tid >> 3, c8 = tid & 7;
    T.k0 = *(const GAS v4u*)(Kb + (size_t)(kb + key0) * 4096 + c16 * 8);
    T.k1 = *(const GAS v4u*)(Kb + (size_t)(kb + key0 + 32) * 4096 + c16 * 8);
    T.v0 = *(const GAS v4u*)(Vtb + (size_t)d0 * MTOK + kb + c8 * 8);
    T.v1 = *(const GAS v4u*)(Vtb + (size_t)(d0 + 64) * MTOK + kb + c8 * 8);
}
__device__ __forceinline__ void tile_store(const TileRegs& T, LAS unsigned char* lds, int buf, int tid) {
    const int key0 = tid >> 4, c16 = tid & 15, d0 = tid >> 3, c8 = tid & 7;
    LAS unsigned char* Kl = lds + ATT_K0 + buf * ATT_KB; LAS unsigned char* Vl = lds + ATT_V0 + buf * ATT_VB;
    *(LAS v4u*)(Kl + kswz(key0, c16 * 16)) = T.k0;
    *(LAS v4u*)(Kl + kswz(key0 + 32, c16 * 16)) = T.k1;
    typedef unsigned v2u __attribute__((ext_vector_type(2)));
    LAS unsigned char* p0 = Vl + d0 * 136 + c8 * 16; LAS unsigned char* p1 = Vl + (d0 + 64) * 136 + c8 * 16;
    *(LAS v2u*)p0 = (v2u){T.v0.x, T.v0.y}; *(LAS v2u*)(p0 + 8) = (v2u){T.v0.z, T.v0.w};
    *(LAS v2u*)p1 = (v2u){T.v1.x, T.v1.y}; *(LAS v2u*)(p1 + 8) = (v2u){T.v1.z, T.v1.w};
}
#define QR_LANDED(q) asm volatile("" : "+v"(q[0]), "+v"(q[1]), "+v"(q[2]), "+v"(q[3]), "+v"(q[4]), "+v"(q[5]), "+v"(q[6]), "+v"(q[7]))
#define MFMA32(a, b, c) __builtin_amdgcn_mfma_f32_32x32x16_bf16((a), (b), (c), 0, 0, 0)
__device__ __forceinline__ void qk_tile(f32x16& p0, f32x16& p1, const LAS unsigned char* Kl, const bf16x8* qr, int r32, int hi) {
    p0 = (f32x16){}; p1 = (f32x16){};
    const int rowoff = r32 * 256, x = (r32 & 15) << 4;
#pragma unroll
    for (int ks = 0; ks < 8; ++ks) { const int off = rowoff + (((2 * ks + hi) * 16) ^ x);
        const bf16x8 a0 = *(const LAS bf16x8*)(Kl + off), a1 = *(const LAS bf16x8*)(Kl + off + 8192);
        p0 = MFMA32(a0, qr[ks], p0); p1 = MFMA32(a1, qr[ks], p1); }
}
__device__ __forceinline__ bf16x8 pack8(const f32x16& p, int b) {
    v4u w; w.x = cvtpk(p[b], p[b + 1]); w.y = cvtpk(p[b + 2], p[b + 3]); w.z = cvtpk(p[b + 4], p[b + 5]); w.w = cvtpk(p[b + 6], p[b + 7]); return __builtin_bit_cast(bf16x8, w);
}
__device__ __forceinline__ void pv_tile(f32x16* o, const LAS unsigned char* Vl, const f32x16& p0, const f32x16& p1, int r32, int hi) {
    const bf16x8 pb0 = pack8(p0, 0), pb1 = pack8(p0, 8), pb2 = pack8(p1, 0), pb3 = pack8(p1, 8);
    const LAS unsigned char* vp = Vl + r32 * 136 + hi * 8;
#pragma unroll
    for (int db = 0; db < 4; ++db) {
#pragma unroll
        for (int s = 0; s < 4; ++s) {
            const s16x4 lo = *(const LAS s16x4*)(vp + db * (32 * 136) + s * 32), h4 = *(const LAS s16x4*)(vp + db * (32 * 136) + s * 32 + 16);
            const bf16x8 a = (bf16x8){lo[0], lo[1], lo[2], lo[3], h4[0], h4[1], h4[2], h4[3]};
            o[db] = MFMA32(a, s == 0 ? pb0 : s == 1 ? pb1 : s == 2 ? pb2 : pb3, o[db]); } }
}
__device__ __forceinline__ void store_ot(const f32x16* o, float sc, bf16* orow, int hi) {
#pragma unroll
    for (int db = 0; db < 4; ++db)
#pragma unroll
        for (int g = 0; g < 4; ++g) { typedef unsigned v2u __attribute__((ext_vector_type(2)));
            v2u w; w.x = cvtpk(o[db][4 * g] * sc, o[db][4 * g + 1] * sc); w.y = cvtpk(o[db][4 * g + 2] * sc, o[db][4 * g + 3] * sc);
            *(GAS v2u*)(orow + db * 32 + g * 8 + hi * 4) = w; }
}

constexpr int CW_GCNT = 32768;
constexpr int PB_STRIDE = 264;
constexpr int S2_PRE_OFF = 135424;
__device__ __forceinline__ void moba_select(Frame& F, int b, int h, int j) {
    const bf16* QK = (const bf16*)(F.ws + WS_QK); const float* KM = (const float*)(F.ws + WS_KMEAN);
    unsigned short* LIST = (unsigned short*)(F.ws + WS_LIST); unsigned* GCNT = (unsigned*)(F.ws + WS_CTL) + CW_GCNT;
    const int lane = lane_id(), w = F.wave, r32 = lane & 31, hi = lane >> 5, tid = w * 64 + lane;
    const int tq = j * 256 + 32 * w + r32, bh = b * NH + h;
    LAS int* cl = (LAS int*)F.lds; LAS int* gb = cl + 32;
    if (tid < 32) cl[tid] = 0;
    const bf16* Qrow = QK + (size_t)(b * SEQ + tq) * 4096 + h * HD;
    bf16x8 qr[8];
#pragma unroll
    for (int ks = 0; ks < 8; ++ks) qr[ks] = *(const GAS bf16x8*)(Qrow + 16 * ks + 8 * hi);
    const float* kmrow = KM + ((size_t)(bh * NBLK + r32)) * HD;
    f32x16 g = (f32x16){};
#pragma unroll
    for (int ks = 0; ks < 8; ++ks) {
        const f32x4 a = *(const GAS f32x4*)(kmrow + 16 * ks + 8 * hi), c = *(const GAS f32x4*)(kmrow + 16 * ks + 8 * hi + 4);
        const float v[8] = {a.x, a.y, a.z, a.w, c.x, c.y, c.z, c.w}; bf16x8 kh, kl;
#pragma unroll
        for (int e = 0; e < 8; ++e) { const unsigned hb = f2bf(v[e]); kh[e] = (short)hb; kl[e] = (short)f2bf(v[e] - bf2f((unsigned short)hb)); }
        g = MFMA32(kh, qr[ks], g); g = MFMA32(kl, qr[ks], g);
    }
    __syncthreads();
    const float NEG = -__builtin_inff();
    float v[16]; int sn[3], pos[3];
#pragma unroll
    for (int r = 0; r < 16; ++r) { const int n = (r & 3) + 8 * (r >> 2) + 4 * hi; v[r] = (n < j) ? g[r] : NEG; }
#pragma unroll
    for (int it = 0; it < 3; ++it) {
        float lm = NEG; int ln = 0;
#pragma unroll
        for (int r = 0; r < 16; ++r) { const int n = (r & 3) + 8 * (r >> 2) + 4 * hi; if (v[r] > lm) { lm = v[r]; ln = n; } }
        float lmB, lnBf; const float lmA = swap_lo(lm, lmB); const float lnAf = swap_lo((float)ln, lnBf);
        const int lnA = (int)lnAf, lnB = (int)lnBf;
        const bool pickA = (lmA > lmB) || (lmA == lmB && lnA < lnB);
        const float wm = pickA ? lmA : lmB; const int wn = pickA ? lnA : lnB;
        const bool ok = wm > NEG;
        sn[it] = ok ? wn : -1; pos[it] = 0;
        if (ok && hi == 0) pos[it] = __hip_atomic_fetch_add(&cl[wn], 1, __ATOMIC_RELAXED, __HIP_MEMORY_SCOPE_WORKGROUP);
        const bool mine = (pickA == (hi == 0));
#pragma unroll
        for (int r = 0; r < 16; ++r) { const int n = (r & 3) + 8 * (r >> 2) + 4 * hi; if (mine && n == wn) v[r] = NEG; }
    }
    __syncthreads();
    if (tid < 32) gb[tid] = cl[tid] ? (int)atomicAdd(&GCNT[bh * NBLK + tid], (unsigned)cl[tid]) : 0;
    __syncthreads();
    if (hi == 0) {
#pragma unroll
        for (int it = 0; it < 3; ++it) if (sn[it] >= 0) LIST[(size_t)(bh * NBLK + sn[it]) * SEQ + gb[sn[it]] + pos[it]] = (unsigned short)(tq | (it << 13));
    }
    __syncthreads();
}
template <int KIND> __device__ __forceinline__ void moba_sweep(Frame& F, const Args& A, CvItem& cvI, int& cv_prev, int& cv_next, const int cv_lim, int b, int h, int blk, int tq, bool valid, int kslot) {
    const bf16* QK = (const bf16*)(F.ws + WS_QK); const bf16* VT = (const bf16*)(F.ws + WS_VT); bf16* AO = (bf16*)(F.ws + WS_AO); unsigned char* PB = F.ws + WS_PB;
    const int lane = lane_id(), w = F.wave, r32 = lane & 31, hi = lane >> 5, tid = w * 64 + lane;
    const int t0 = blk * 256;
    const bf16* Qrow = QK + (size_t)(b * SEQ + tq) * 4096 + h * HD;
    const bf16* Kb = QK + (size_t)(b * SEQ) * 4096 + 2048 + h * HD;
    const bf16* Vtb = VT + (size_t)(h * HD) * MTOK + b * SEQ;
    bf16x8 qr[8];
#pragma unroll
    for (int ks = 0; ks < 8; ++ks) qr[ks] = *(const GAS bf16x8*)(Qrow + 16 * ks + 8 * hi);
    const float slope2 = exp2f(-0.5f * (float)(h + 1)) * 1.4426950408889634f;
    const float C2 = 0.08838834764831845f * 1.4426950408889634f;
    float m = -1e30f, l = 0.f; f32x16 o[4] = {};
    TileRegs T;
    tile_load(T, Kb, Vtb, t0 + 192, tid);
    { const bool ok = cv_next < cv_lim; cv_decode(A, F.ws, ok ? cv_next : CV_EARLY, cvI, ok); cv_issue(cvI, F.lds + CV_SCR_OFF + w * CV_SCR_BYTES, lane); cv_prev = ok ? cv_next : CV_NONE; cv_next += ok ? F.G * NWAVES : 0; }
    tile_store(T, F.lds, 0, tid);
    LDS_BARRIER();
    QR_LANDED(qr);
#pragma unroll 1
    for (int t = 0; t < 4; ++t) {
        const int kb = t0 + 192 - 64 * t, buf = t & 1;
        if (t + 1 < 4) tile_load(T, Kb, Vtb, kb - 64, tid);
        asm volatile("" ::: "memory");
        bool act = true, needmask = false;
        if (KIND == 3) { act = (kb <= t0 + 32 * w + 31); needmask = (kb + 63 > t0 + 32 * w); }
        if (act) {
            f32x16 p0, p1;
            qk_tile(p0, p1, F.lds + ATT_K0 + buf * ATT_KB, qr, r32, hi);
            const float NEG = -__builtin_inff();
            const float T0 = slope2 * (float)(kb + 4 * hi - tq), T1 = T0 + 32.0f * slope2;
            const int dq = tq - kb - 4 * hi;
            float mx0 = NEG, mx1 = NEG; float s2v = slope2; asm volatile("" : "+v"(s2v));
#pragma unroll
            for (int r = 0; r < 16; ++r) { const int c = (r & 3) + 8 * (r >> 2); const float bc = s2v * (float)c;
                float x0 = fmaf(p0[r], C2, bc), x1 = fmaf(p1[r], C2, bc);
                if (needmask) { if (c > dq) x0 = NEG; if (c + 32 > dq) x1 = NEG; }
                p0[r] = x0; p1[r] = x1; mx0 = fmaxf(mx0, x0); mx1 = fmaxf(mx1, x1); }
            float cand = fmaxf(mx0 + T0, mx1 + T1);
            { float cb; const float ca = swap_lo(cand, cb); cand = fmaxf(ca, cb); }
            if (__any(cand > m + 8.0f)) {
                const float mn = fmaxf(m, cand), alpha = __builtin_amdgcn_exp2f(m - mn);
                l *= alpha; m = mn;
#pragma unroll
                for (int db = 0; db < 4; ++db)
#pragma unroll
                    for (int r = 0; r < 16; ++r) o[db][r] *= alpha;
            }
            const float d0 = T0 - m, d1 = T1 - m; float ps = 0.f;
#pragma unroll
            for (int r = 0; r < 16; ++r) { p0[r] = __builtin_amdgcn_exp2f(p0[r] + d0); p1[r] = __builtin_amdgcn_exp2f(p1[r] + d1); ps += p0[r] + p1[r]; }
            l += ps;
            pv_tile(o, F.lds + ATT_V0 + buf * ATT_VB, p0, p1, r32, hi);
        }
        if (cv_prev < CV_NONE) cv_finish(cvI, F.lds + CV_SCR_OFF + w * CV_SCR_BYTES, lane, (const LAS float*)(F.lds + CV_G2_OFF), true);
        if (t + 1 < 4) tile_store(T, F.lds, buf ^ 1, tid);
        if (t + 1 < 4 && cv_next < cv_lim) { cv_decode(A, F.ws, cv_next, cvI); cv_issue(cvI, F.lds + CV_SCR_OFF + w * CV_SCR_BYTES, lane); cv_prev = cv_next; cv_next += F.G * NWAVES; } else cv_prev = CV_NONE;
        LDS_BARRIER();
    }
    { float lb; const float la = swap_lo(l, lb); l = la + lb; }
    const size_t qidx = (size_t)((b * NH + h) * SEQ + tq) * 3;
    if (KIND == 2) {
        if (valid) { unsigned char* pb = PB + (qidx + kslot) * PB_STRIDE; typedef unsigned v2u __attribute__((ext_vector_type(2)));
#pragma unroll
            for (int db = 0; db < 4; ++db)
#pragma unroll
                for (int g = 0; g < 4; ++g) { v2u wv; wv.x = cvtpk(o[db][4 * g], o[db][4 * g + 1]); wv.y = cvtpk(o[db][4 * g + 2], o[db][4 * g + 3]); *(GAS v2u*)(pb + (db * 32 + g * 8 + hi * 4) * 2) = wv; }
            if (hi == 0) { *(GAS f32x2v*)(pb + 256) = (f32x2v){m, l}; } }
    } else {
        const int nv = blk < 3 ? blk : 3;
        for (int k = 0; k < nv; ++k) { const unsigned char* pb = PB + (qidx + k) * PB_STRIDE; typedef unsigned v2u __attribute__((ext_vector_type(2)));
            const f32x2v ml = *(const GAS f32x2v*)(pb + 256);
            const float mk = ml.x, lk = ml.y, M = fmaxf(m, mk), sa = __builtin_amdgcn_exp2f(m - M), sb = __builtin_amdgcn_exp2f(mk - M);
            l = l * sa + lk * sb; m = M;
#pragma unroll
            for (int db = 0; db < 4; ++db)
#pragma unroll
                for (int g = 0; g < 4; ++g) { const v2u pv = *(const GAS v2u*)(pb + (db * 32 + g * 8 + hi * 4) * 2);
                    o[db][4 * g] = o[db][4 * g] * sa + __uint_as_float(pv.x << 16) * sb; o[db][4 * g + 1] = o[db][4 * g + 1] * sa + __uint_as_float(pv.x & 0xffff0000u) * sb; o[db][4 * g + 2] = o[db][4 * g + 2] * sa + __uint_as_float(pv.y << 16) * sb; o[db][4 * g + 3] = o[db][4 * g + 3] * sa + __uint_as_float(pv.y & 0xffff0000u) * sb; } }
        store_ot(o, 1.0f / l, AO + (size_t)(b * SEQ + tq) * DM + h * HD, hi);
    }
    __syncthreads();
}

__device__ __forceinline__ void sb_unit(Frame& F, const Args& A, CvItem& cvI, int& cv_prev, int& cv_next, const int cv_lim, int b, int h, int qb) {
    const bf16* QK = (const bf16*)(F.ws + WS_QK); const bf16* VT = (const bf16*)(F.ws + WS_VT); bf16* AO = (bf16*)(F.ws + WS_AO);
    const int tid = (F.wave * 64 + lane_id()), lane = lane_id(), w = F.wave, r32 = lane & 31, hi = lane >> 5;
    const int t0 = qb * 256, tq = t0 + 32 * w + r32;
    const bf16* Qrow = QK + (size_t)(b * SEQ + tq) * 4096 + h * HD;
    const bf16* Kb = QK + (size_t)(b * SEQ) * 4096 + 2048 + h * HD;
    const bf16* Vtb = VT + (size_t)(h * HD) * MTOK + b * SEQ;
    bf16x8 qr[8];
#pragma unroll
    for (int ks = 0; ks < 8; ++ks) qr[ks] = *(const GAS bf16x8*)(Qrow + 16 * ks + 8 * hi);
    const float C2 = 0.08838834764831845f * 1.4426950408889634f;
    float R = 0.f; f32x16 o[4] = {}; bool done = false;
    volatile LAS unsigned* flags = (volatile LAS unsigned*)(F.lds + ATT_FLAGS);
    TileRegs T;
    const int ktop = 4 * qb + 3;
    tile_load(T, Kb, Vtb, 64 * ktop, tid); tile_store(T, F.lds, 0, tid);
    __syncthreads();
    QR_LANDED(qr);
    for (int it = 0;; ++it) {
        const int kb = 64 * (ktop - it), buf = it & 1; const bool more = kb > 0;
        if (more) tile_load(T, Kb, Vtb, kb - 64, tid);
        const bool act = !done && (kb < t0 + 32 * w + 31);
        if (act) {
            const bool needmask = (kb + 63 >= t0 + 32 * w);
            f32x16 p0, p1;
            qk_tile(p0, p1, F.lds + ATT_K0 + buf * ATT_KB, qr, r32, hi);
            const int dq = tq - kb - 4 * hi;
            f32x16 k0, k1;
            float s0[4], s1[4];
#pragma unroll
            for (int g = 0; g < 4; ++g) { s0[g] = 0.f; s1[g] = 0.f; }
#pragma unroll
            for (int r = 0; r < 16; ++r) { const int c = (r & 3) + 8 * (r >> 2);
                const float u0 = p0[r] * C2, u1 = p1[r] * C2;
                float a0 = fminf(-u0, 0.f) - __builtin_amdgcn_logf(1.0f + __builtin_amdgcn_exp2f(-fabsf(u0)));
                float a1 = fminf(-u1, 0.f) - __builtin_amdgcn_logf(1.0f + __builtin_amdgcn_exp2f(-fabsf(u1)));
                if (needmask) { if (!(c < dq)) a0 = 0.f; if (!(c + 32 < dq)) a1 = 0.f; }
                p0[r] = u0; p1[r] = u1; k0[r] = a0; k1[r] = a1; s0[r >> 2] += a0; s1[r >> 2] += a1; }
            float run = R, off0[4], off1[4];
#pragma unroll
            for (int g = 3; g >= 0; --g) { float sb; const float sa = swap_lo(s1[g], sb); const float o_hi1 = run; run += sb; const float o_hi0 = run; run += sa; off1[g] = hi ? o_hi1 : o_hi0; }
#pragma unroll
            for (int g = 3; g >= 0; --g) { float sb; const float sa = swap_lo(s0[g], sb); const float o_hi1 = run; run += sb; const float o_hi0 = run; run += sa; off0[g] = hi ? o_hi1 : o_hi0; }
            R = run;
#pragma unroll
            for (int g = 0; g < 4; ++g) { float c0 = off0[g], c1 = off1[g];
#pragma unroll
                for (int i = 3; i >= 0; --i) { const int r = 4 * g + i, c = (r & 3) + 8 * (r >> 2);
                    c0 += k0[r]; c1 += k1[r];
                    float w0 = __builtin_amdgcn_exp2f(p0[r] + c0), w1 = __builtin_amdgcn_exp2f(p1[r] + c1);
                    if (needmask) { if (!(c < dq)) w0 = 0.f; if (!(c + 32 < dq)) w1 = 0.f; }
                    p0[r] = w0; p1[r] = w1; } }
            pv_tile(o, F.lds + ATT_V0 + buf * ATT_VB, p0, p1, r32, hi);
            done = __all(R < -152.0f);
        }
        if (lane == 0) flags[(it & 1) * 8 + w] = done ? 1u : 0u;
        if (cv_prev < CV_NONE) cv_finish(cvI, F.lds + CV_SCR_OFF + w * CV_SCR_BYTES, lane, (const LAS float*)(F.lds + CV_G2_OFF), true);
        if (more) tile_store(T, F.lds, buf ^ 1, tid);
        if (cv_next < cv_lim) { cv_decode(A, F.ws, cv_next, cvI); cv_issue(cvI, F.lds + CV_SCR_OFF + w * CV_SCR_BYTES, lane); cv_prev = cv_next; cv_next += F.G * NWAVES; } else cv_prev = CV_NONE;
        LDS_BARRIER();
        unsigned nd = 0;
#pragma unroll
        for (int i = 0; i < 8; ++i) nd += flags[(it & 1) * 8 + i];
        if (nd == 8u || !more) break;
    }
    store_ot(o, 1.0f, AO + (size_t)(b * SEQ + tq) * DM + h * HD, hi);
    __syncthreads();
}

__device__ __forceinline__ void moe_tail_reduce(unsigned char* ws) {
    const int cid = (int)blockIdx.x;
    const int* META = (const int*)(ws + WS_META); const int P = __builtin_amdgcn_readfirstlane(META[8]);
    const int nwg = P * (DM / 256), G = (int)gridDim.x, full = nwg / G, tpx = (nwg - full * G) / 8;
    const int x = cid % 8, j = cid / 8, tu = j >> 2, q = j & 3;
    if (G != 256 || (nwg % 8) != 0 || tpx > 8 || tu >= tpx) return;
    pg8::StaticOrder so; so.init(P * 256, DM, G, cid); pg8::Unit u; if (!so.at((long)full * G + tu * 8 + x, u)) return;
    const float* T = (const float*)(ws + WS_SLAB) + (size_t)((x * 8 + tu) * 4) * 65536; bf16* YS = (bf16*)(ws + WS_YS);
    const int tid = (int)threadIdx.x;
#pragma unroll
    for (int i = 0; i < 8; ++i) { const int idx = tid + 512 * i, row = 64 * q + (idx >> 6), c4 = idx & 63;
        const GAS f32x4* p = (const GAS f32x4*)(T + row * 256 + c4 * 4);
        const f32x4 s = (p[0] + p[65536 / 4]) + (p[2 * 65536 / 4] + p[3 * 65536 / 4]);
        typedef unsigned v2u __attribute__((ext_vector_type(2)));
        v2u w; w.x = cvtpk(s.x, s.y); w.y = cvtpk(s.z, s.w);
        *(GAS v2u*)(YS + (size_t)(u.pm * 256 + row) * DM + u.pn * 256 + c4 * 4) = w; }
}

__device__ __forceinline__ void router_phase(Frame& F) {
    const float* H = (const float*)(F.ws + WS_H); bf16* Y = (bf16*)(F.ws + WS_Y);
    int* TOKE = (int*)(F.ws + WS_TOKE); float* TOKG = (float*)(F.ws + WS_TOKG); int* TOKR = (int*)(F.ws + WS_TOKR); int* CNT = (int*)(F.ws + WS_CNT);
    LAS float* wl = (LAS float*)F.lds;
    LAS int* te = (LAS int*)(F.lds + 65536);
    { const GAS f32x4* src = (const GAS f32x4*)(F.ws + WS_WRG); LAS f32x4* dst = (LAS f32x4*)wl; for (int i = (F.wave * 64 + lane_id()); i < NE * DM / 4; i += NWAVES * 64) dst[i] = src[i]; }
    __syncthreads();
    const int rows_per_wg = MTOK / F.G, rows_per_wave = rows_per_wg / NWAVES;
    const int row0 = F.vcu * rows_per_wg + F.wave * rows_per_wave;
    for (int i = 0; i < rows_per_wave; ++i) {
        const int m = row0 + i;
        const GAS f32x4* xr = (const GAS f32x4*)(H + (size_t)m * DM) + lane_id();
        f32x4 v[8]; float s = 0.f;
#pragma unroll
        for (int j = 0; j < 8; ++j) { v[j] = xr[64 * j]; s += (v[j].x * v[j].x + v[j].y * v[j].y) + (v[j].z * v[j].z + v[j].w * v[j].w); }
        const float r = 1.0f / sqrtf(wave_sum(s) * (1.0f / DM) + RMS_EPS);
        GAS unsigned long long* o8 = (GAS unsigned long long*)(Y + (size_t)m * DM) + lane_id();
#pragma unroll
        for (int j = 0; j < 8; ++j) o8[64 * j] = (unsigned long long)cvtpk(v[j].x * r, v[j].y * r) | ((unsigned long long)cvtpk(v[j].z * r, v[j].w * r) << 32);
        float lg[NE];
#pragma unroll
        for (int e = 0; e < NE; ++e) { float a = 0.f;
#pragma unroll
            for (int j = 0; j < 8; ++j) { const f32x4 wv = *(const LAS f32x4*)(wl + e * DM + 256 * j + 4 * lane_id()); a += (v[j].x * wv.x + v[j].y * wv.y) + (v[j].z * wv.z + v[j].w * wv.w); }
            lg[e] = wave_sum(a) * r; }
        int i0 = 0; float l0 = lg[0];
#pragma unroll
        for (int e = 1; e < NE; ++e) if (lg[e] > l0) { l0 = lg[e]; i0 = e; }
        int i1 = -1; float l1 = -__builtin_inff();
#pragma unroll
        for (int e = 0; e < NE; ++e) if (e != i0 && lg[e] > l1) { l1 = lg[e]; i1 = e; }
        const float ex = expf(l1 - l0), g0 = 1.0f / (1.0f + ex), g1 = ex / (1.0f + ex);
        if (lane_id() == 0) { TOKE[2 * m] = i0; TOKE[2 * m + 1] = i1; TOKG[2 * m] = g0; TOKG[2 * m + 1] = g1; const int lr = m - F.vcu * rows_per_wg; te[2 * lr] = i0; te[2 * lr + 1] = i1; }
    }
    __syncthreads();
    if ((F.wave * 64 + lane_id()) < NE) { int c = 0; const int mb = F.vcu * rows_per_wg;
        for (int t = 0; t < rows_per_wg; ++t) {
#pragma unroll
            for (int k = 0; k < 2; ++k) if (te[2 * t + k] == (F.wave * 64 + lane_id())) { TOKR[2 * (mb + t) + k] = c; ++c; } }
        CNT[F.vcu * NE + (F.wave * 64 + lane_id())] = c; }
    __syncthreads();
}
__device__ __forceinline__ void scatter_phase(Frame& F) {
    const bf16* Y = (const bf16*)(F.ws + WS_Y); unsigned char* XS = (unsigned char*)(F.ws + WS_XS);
    const int* TOKE = (const int*)(F.ws + WS_TOKE); const int* TOKR = (const int*)(F.ws + WS_TOKR); int* TOKP = (int*)(F.ws + WS_TOKP); const int* CNT = (const int*)(F.ws + WS_CNT); int* META = (int*)(F.ws + WS_META);
    LAS int* cl = (LAS int*)F.lds;
    LAS int* tot = (LAS int*)(F.lds + 16384);
    for (int i = (F.wave * 64 + lane_id()); i < F.G * NE; i += NWAVES * 64) cl[i] = CNT[i];
    __syncthreads();
    if ((F.wave * 64 + lane_id()) < NE) { int t = 0, p = 0; for (int g = 0; g < F.G; ++g) { const int c = cl[g * NE + (F.wave * 64 + lane_id())]; if (g < F.vcu) p += c; t += c; } tot[(F.wave * 64 + lane_id())] = t; tot[8 + (F.wave * 64 + lane_id())] = p; }
    __syncthreads();
    if ((F.wave * 64 + lane_id()) == 0) { int ts = 0; for (int e = 0; e < NE; ++e) { tot[16 + e] = ts; tot[32 + e] = ts * 256 + tot[8 + e]; ts += (tot[e] + 255) / 256; } tot[16 + NE] = ts;
        if (F.vcu == 0) { for (int e = 0; e <= NE; ++e) META[e] = tot[16 + e]; } }
    __syncthreads();
    const int rows_per_wg = MTOK / F.G, rows_per_wave = rows_per_wg / NWAVES;
    const int row0 = F.vcu * rows_per_wg + F.wave * rows_per_wave;
    for (int i = 0; i < rows_per_wave; ++i) { const int m = row0 + i;
        const GAS v4u* src = (const GAS v4u*)(Y + (size_t)m * DM) + lane_id();
        typedef unsigned v2u __attribute__((ext_vector_type(2)));
        v2u q[4];
#pragma unroll
        for (int j = 0; j < 4; ++j) { const v4u v = src[64 * j];
            q[j].x = pg8::pk4_fp8(__uint_as_float(v.x << 16) * F8_ASCALE, __uint_as_float(v.x & 0xffff0000u) * F8_ASCALE, __uint_as_float(v.y << 16) * F8_ASCALE, __uint_as_float(v.y & 0xffff0000u) * F8_ASCALE);
            q[j].y = pg8::pk4_fp8(__uint_as_float(v.z << 16) * F8_ASCALE, __uint_as_float(v.z & 0xffff0000u) * F8_ASCALE, __uint_as_float(v.w << 16) * F8_ASCALE, __uint_as_float(v.w & 0xffff0000u) * F8_ASCALE); }
#pragma unroll
        for (int k = 0; k < 2; ++k) { const int e = TOKE[2 * m + k], pos = tot[32 + e] + TOKR[2 * m + k];
            if (lane_id() == 0) TOKP[2 * m + k] = pos;
            GAS v2u* dst = (GAS v2u*)(XS + (size_t)pos * DM) + lane_id();
#pragma unroll
            for (int j = 0; j < 4; ++j) dst[64 * j] = q[j]; } }
    __syncthreads();
}
__device__ __forceinline__ void combine_phase(Frame& F, const float* gf, float* outp) {
    const int lane_c = lane_id_fresh();
    const float* H = (const float*)(F.ws + WS_H); const bf16* YS = (const bf16*)(F.ws + WS_YS); const int* TOKP = (const int*)(F.ws + WS_TOKP); const float* TOKG = (const float*)(F.ws + WS_TOKG);
    const int gw = F.vcu * NWAVES + F.wave, NGW = F.G * NWAVES;
    for (int m = gw; m < MTOK; m += NGW) {
        const int p0 = TOKP[2 * m], p1 = TOKP[2 * m + 1]; const float g0 = TOKG[2 * m], g1 = TOKG[2 * m + 1];
        const GAS f32x4* xr = (const GAS f32x4*)(H + (size_t)m * DM) + lane_c; typedef unsigned v2u __attribute__((ext_vector_type(2)));
        const GAS v2u* y0 = (const GAS v2u*)(YS + (size_t)p0 * DM) + lane_c; const GAS v2u* y1 = (const GAS v2u*)(YS + (size_t)p1 * DM) + lane_c;
        f32x4 v[8]; float s = 0.f;
#pragma unroll
        for (int j = 0; j < 8; ++j) { const v2u a0 = y0[64 * j], a1 = y1[64 * j];
            const f32x4 e0 = {__uint_as_float(a0.x << 16), __uint_as_float(a0.x & 0xffff0000u), __uint_as_float(a0.y << 16), __uint_as_float(a0.y & 0xffff0000u)}, e1 = {__uint_as_float(a1.x << 16), __uint_as_float(a1.x & 0xffff0000u), __uint_as_float(a1.y << 16), __uint_as_float(a1.y & 0xffff0000u)};
            v[j] = xr[64 * j] + (e0 * g0 + e1 * g1); s += (v[j].x * v[j].x + v[j].y * v[j].y) + (v[j].z * v[j].z + v[j].w * v[j].w); }
        const float r = 1.0f / sqrtf(wave_sum_l(s, lane_c) * (1.0f / DM) + RMS_EPS);
        GAS f32x4* orow = (GAS f32x4*)(outp + (size_t)m * DM) + lane_c; const GAS f32x4* gr = (const GAS f32x4*)gf + lane_c;
#pragma unroll
        for (int j = 0; j < 8; ++j) orow[64 * j] = v[j] * r * gr[64 * j];
    }
}

__global__ void __launch_bounds__(NWAVES * 64, 2) yoco_fwd(Args args) {
    extern __shared__ __attribute__((aligned(16))) unsigned char lds[];
    Frame F;
    F.lds = (LAS unsigned char*)lds;
    F.MISC = (volatile LAS unsigned*)(F.lds + MISC_OFF);
    F.wave = __builtin_amdgcn_readfirstlane((int)threadIdx.x >> 6);
    F.G = gridDim.x; { const int bx = blockIdx.x; F.vcu = (F.G % 8 == 0) ? (bx % 8) * (F.G / 8) + bx / 8 : bx; }
    unsigned char* ws = args.ws; F.ws = ws;

    F.ctl = (gu32*)(ws + WS_CTL);
    for (int u = (F.wave * 64 + lane_id()); u < (LDS_BYTES - MISC_OFF) / 4; u += NWAVES * 64) ((LAS unsigned*)(F.lds + MISC_OFF))[u] = 0u;
    __syncthreads();
    XcdBarrier bar; bar.bar = (unsigned*)(F.ctl + CW_BAR); bar.x = 0; bar.st = nullptr; bar.wave = F.wave;
    if (N_LAUNCHES == 1) bar = xcd_barrier_post((unsigned*)(F.ctl + CW_BAR), F.MISC + 8, F.wave);
#define GRID_BAR() do { if (N_LAUNCHES == 1) { XcdBarrier b_; b_.bar = (unsigned*)((gu32*)(F.ws + WS_CTL) + CW_BAR); b_.x = bar.x; b_.wave = F.wave; b_.st = (volatile LAS unsigned*)(F.lds + MISC_OFF) + 8; xcd_barrier(b_); } } while (0)
    const int lo = args.ph_lo, hi = args.ph_hi;
#if defined(DBG) && DBG
    if (lo >= 1000) { dbg_check(F, args, lo - 1000); return; }
#endif
#define IN(k) (lo <= (k) && (k) < hi)
#ifndef PROBE_REP_PHASE
#define PROBE_REP_PHASE -1
#endif
#define REPN(k) ((k) == PROBE_REP_PHASE ? 2 : 1)
#ifdef PROBE_T
#define PT_STAMP(slot) do { if (blockIdx.x == 0 && threadIdx.x == 0) __hip_atomic_store((unsigned*)((gu32*)(F.ws + WS_CTL) + 8 + (slot)), (unsigned)__builtin_amdgcn_s_memrealtime(), __ATOMIC_RELAXED, __HIP_MEMORY_SCOPE_AGENT); } while (0)
#define SEAM(k) do { if (IN(k) && IN((k) + 1)) GRID_BAR(); if ((k) + 1 == PROBE_T) PT_STAMP(0); if ((k) + 1 == PROBE_T_END) PT_STAMP(1); } while (0)
#else
#define SEAM(k) do { if (IN(k) && IN((k) + 1)) GRID_BAR(); } while (0)
#endif
    LAS unsigned char* ring = F.lds;
    const int cid = (int)blockIdx.x;

    if (IN(0)) { p0_prologue(F, args); } SEAM(0);
    if (IN(1)) {
        { pg8::Gemm g{(const bf16*)(ws + WS_Y), (const bf16*)(ws + WS_WQK0), MTOK, 4096, DM}; pg8::StaticOrder S; S.init(MTOK, 4096, F.G, cid);
          pg8::EpiBf16Kmean E{(bf16*)(ws + WS_QK), 4096, (float*)(ws + WS_KMEAN)}; pg8::gemm_phase<pg8::EpiBf16Kmean, pg8::StaticOrder, false, true>(ring, g, S, E, F.wave); }
        { pg8::Gemm g{(const bf16*)(ws + WS_WV0), (const bf16*)(ws + WS_Y), DM, MTOK, DM}; pg8::StaticOrder S; S.init(DM, MTOK, F.G, cid);
          pg8::EpiBf16 E{(bf16*)(ws + WS_VT), MTOK}; pg8::gemm_phase<pg8::EpiBf16, pg8::StaticOrder, false, true>(ring, g, S, E, F.wave); }
    } SEAM(1);
    if (IN(3)) {
        const int v = F.vcu, bh = v >> 3;
        for (int i = 0; i < 4; ++i) { const int j = (v & 7) + 8 * i; if (j > 0) moba_select(F, bh / NH, bh % NH, j); }
    } SEAM(3);
    int cv_prev = CV_NONE, cv_next = CV_EARLY + F.vcu * NWAVES + F.wave;
    const int cv_split = CV_EARLY + CV_SPLIT_PER_WAVE * F.G * NWAVES;
    CvItem cvI;
    if (IN(4)) {
        const unsigned* GCNT = (const unsigned*)(ws + WS_CTL) + CW_GCNT; const unsigned short* LIST = (const unsigned short*)(ws + WS_LIST);
        LAS unsigned short* pre = (LAS unsigned short*)(F.lds + S2_PRE_OFF);
        cv_load_g2(F, args);
        for (int i = F.wave * 64 + lane_id(); i < BATCH * NH * NBLK; i += NWAVES * 64) pre[i + 1] = (unsigned short)((GCNT[i] + 255u) >> 8);
        __syncthreads();
        if (F.wave == 0) { const int ln = lane_id(); int cv[16]; int s = 0;
#pragma unroll
            for (int i = 0; i < 16; ++i) { cv[i] = pre[1 + 16 * ln + i]; s += cv[i]; }
            int incl = s;
#pragma unroll
            for (int o = 1; o < 64; o <<= 1) { const int t = __shfl_up(incl, o); if (ln >= o) incl += t; }
            int run = incl - s;
#pragma unroll
            for (int i = 0; i < 16; ++i) { run += cv[i]; pre[1 + 16 * ln + i] = (unsigned short)run; }
            if (ln == 0) pre[0] = 0; }
        __syncthreads();
        const int T = pre[BATCH * NH * NBLK];
        int item = F.vcu; int c_idx = 0, c_c = 0; unsigned c_cnt = 0, c_val = 0;
#define S2_FETCH(it_, idx_, c_, cnt_, val_) do { int lo_ = 0, hi_ = BATCH * NH * NBLK;                         \
            while (hi_ - lo_ > 1) { const int mid = (lo_ + hi_) >> 1; if ((int)pre[mid] <= (it_)) lo_ = mid; else hi_ = mid; } \
            idx_ = __builtin_amdgcn_readfirstlane(lo_); c_ = (it_) - (int)pre[idx_]; cnt_ = GCNT[idx_]; \
            val_ = LIST[(size_t)idx_ * SEQ + 256 * c_ + 32 * F.wave + (lane_id() & 31)]; } while (0)
        if (item < T) S2_FETCH(item, c_idx, c_c, c_cnt, c_val);
        while (item < T) {
            const int nitem = item + F.G; int n_idx = 0, n_c = 0; unsigned n_cnt = 0, n_val = 0;
            if (nitem < T) S2_FETCH(nitem, n_idx, n_c, n_cnt, n_val);
            const int bh = c_idx >> 5, n = c_idx & 31; const bool valid = (unsigned)(256 * c_c + 32 * F.wave + (lane_id() & 31)) < c_cnt;
            moba_sweep<2>(F, args, cvI, cv_prev, cv_next, cv_split - 16 * F.G * NWAVES, bh / NH, bh % NH, n, (int)(c_val & 8191u), valid, (int)((c_val >> 13) & 3u));
            item = nitem; c_idx = n_idx; c_c = n_c; c_cnt = n_cnt; c_val = n_val;
        }
#undef S2_FETCH
    } SEAM(4);
    if (IN(5)) {
        const int v = F.vcu, s = v & 7, bh = v >> 3;
        if (N_LAUNCHES != 1) { cv_load_g2(F, args); __syncthreads(); }
        for (int i = 0; i < 4; ++i) { const int j = (i == 0) ? s : (i == 1) ? 15 - s : (i == 2) ? 16 + s : 31 - s;
            moba_sweep<3>(F, args, cvI, cv_prev, cv_next, cv_split, bh / NH, bh % NH, j, j * 256 + 32 * F.wave + (lane_id() & 31), true, 0); }
        { LAS unsigned char* scr = F.lds + CV_SCR_OFF + F.wave * CV_SCR_BYTES;
          if (cv_prev < CV_NONE) cv_finish(cvI, scr, lane_id());
          cv_stream(F, args, cv_next, cv_split); }
    } SEAM(5);
    if (IN(6)) {
        pg8::Gemm g{(const bf16*)(ws + WS_AO), (const bf16*)(ws + WS_WO0), MTOK, DM, DM}; pg8::StaticOrder S; S.init(MTOK, DM, F.G, cid);
        pg8::EpiResF32 E{args.in[0], (float*)(ws + WS_H), DM, 1.0f}; pg8::gemm_phase<pg8::EpiResF32, pg8::StaticOrder, false, true>(ring, g, S, E, F.wave);
    } SEAM(6);
    if (IN(7)) { norm_rows_i8(F, (const float*)(ws + WS_H), (unsigned char*)(ws + WS_Y), (float*)(ws + WS_SY), args.in[2]); } SEAM(7);
    if (IN(8)) {
        pg8::Gemm g{(const bf16*)(ws + WS_Y), (const bf16*)(ws + WS_W13D), MTOK, 2 * FFD, DM / 2}; pg8::StaticOrder S; S.init(MTOK, 2 * FFD, F.G, cid);
        float* swp = (float*)(ws + WS_SY) + MTOK;
        if (F.wave == 0 && lane_id() == 0) *swp = __uint_as_float(__hip_atomic_load((const unsigned*)(F.ctl + CW_AMAXW), __ATOMIC_RELAXED, __HIP_MEMORY_SCOPE_AGENT)) * (1.0f / 127.0f);
        __syncthreads();
        pg8::EpiSwiGLUI8 E{(bf16*)(ws + WS_HID), FFD, (const float*)(ws + WS_SY), swp}; pg8::gemm_phase<pg8::EpiSwiGLUI8, pg8::StaticOrder, true, true, false, true>(ring, g, S, E, F.wave);
    } SEAM(8);
    if (IN(9)) {
        pg8::Gemm g{(const bf16*)(ws + WS_HID), (const bf16*)(ws + WS_W2D), MTOK, DM, FFD}; pg8::StaticOrder S; S.init(MTOK, DM, F.G, cid);
        pg8::EpiResF32 E{(const float*)(ws + WS_H), (float*)(ws + WS_H), DM, 1.0f}; pg8::gemm_phase<pg8::EpiResF32, pg8::StaticOrder, true, true>(ring, g, S, E, F.wave);
    } SEAM(9);
    if (IN(10)) { norm_rows(F, (const float*)(ws + WS_H), (bf16*)(ws + WS_Y)); } SEAM(10);
    if (IN(11)) {
        { pg8::Gemm g{(const bf16*)(ws + WS_Y), (const bf16*)(ws + WS_WQK1), MTOK, 4096, DM}; pg8::StaticOrder S; S.init(MTOK, 4096, F.G, cid);
          pg8::EpiBf16 E{(bf16*)(ws + WS_QK), 4096}; pg8::gemm_phase<pg8::EpiBf16, pg8::StaticOrder, false, true>(ring, g, S, E, F.wave); }
        { pg8::Gemm g{(const bf16*)(ws + WS_WV1), (const bf16*)(ws + WS_Y), DM, MTOK, DM}; pg8::StaticOrder S; S.init(DM, MTOK, F.G, cid);
          pg8::EpiBf16 E{(bf16*)(ws + WS_VT), MTOK}; pg8::gemm_phase<pg8::EpiBf16, pg8::StaticOrder, false, true>(ring, g, S, E, F.wave); }
    } SEAM(11);
    if (IN(12)) {
        cv_prev = CV_NONE; cv_next = cv_split + F.vcu * NWAVES + F.wave;
        cv_load_g2(F, args); __syncthreads();
        for (int i = 0; i < 4; ++i) { const int v = F.vcu; if (v >= BATCH * NH * 8) break; sb_unit(F, args, cvI, cv_prev, cv_next, CV_EARLY + CV_LATE, (v >> 3) / NH, (v >> 3) % NH, (v & 7) + 8 * i); }
        { LAS unsigned char* scr = F.lds + CV_SCR_OFF + F.wave * CV_SCR_BYTES;
          if (cv_prev < CV_NONE) cv_finish(cvI, scr, lane_id());
          cv_stream(F, args, cv_next, CV_EARLY + CV_LATE); }
    } SEAM(12);
    if (IN(13)) {
        pg8::Gemm g{(const bf16*)(ws + WS_AO), (const bf16*)(ws + WS_WO1), MTOK, DM, DM}; pg8::StaticOrder S; S.init(MTOK, DM, F.G, cid);
        pg8::EpiResF32 E{(const float*)(ws + WS_H), (float*)(ws + WS_H), DM, 1.0f}; pg8::gemm_phase<pg8::EpiResF32, pg8::StaticOrder, false, true>(ring, g, S, E, F.wave);
    } SEAM(13);
    if (IN(14)) { router_phase(F); } SEAM(14);
    if (IN(15)) { scatter_phase(F); } SEAM(15);
    if (IN(16)) {
        const int* META = (const int*)(ws + WS_META); const int P = __builtin_amdgcn_readfirstlane(META[8]);
        pg8::Gemm g{(const bf16*)(ws + WS_XS), (const bf16*)(ws + WS_W13M), P * 256, 2 * FFE, DM / 2};
        pg8::MoeOrder S; S.so.init(P * 256, 2 * FFE, F.G, cid); S.t1 = __builtin_amdgcn_readfirstlane(META[1]); S.t2 = __builtin_amdgcn_readfirstlane(META[2]); S.t3 = __builtin_amdgcn_readfirstlane(META[3]); S.t4 = __builtin_amdgcn_readfirstlane(META[4]); S.t5 = __builtin_amdgcn_readfirstlane(META[5]); S.t6 = __builtin_amdgcn_readfirstlane(META[6]); S.t7 = __builtin_amdgcn_readfirstlane(META[7]); S.estride = (size_t)2 * FFE * DM;
        pg8::EpiSwiGLU8<FFE> E{(unsigned char*)(ws + WS_HID), 1.0f / (F8_ASCALE * F8_WSCALE), F8_HSCALE}; pg8::gemm_phase<pg8::EpiSwiGLU8<FFE>, pg8::MoeOrder, true, true, true>(ring, g, S, E, F.wave);
    } SEAM(16);
    if (IN(17)) {
        const int* META = (const int*)(ws + WS_META); const int P = __builtin_amdgcn_readfirstlane(META[8]);
        pg8::Gemm g{(const bf16*)(ws + WS_HID), (const bf16*)(ws + WS_W2M), P * 256, DM, FFE / 2};
        pg8::MoeTailOrder<FFE / 128, FFE / 4> S; S.mo.so.init(P * 256, DM, F.G, cid); S.mo.t1 = __builtin_amdgcn_readfirstlane(META[1]); S.mo.t2 = __builtin_amdgcn_readfirstlane(META[2]); S.mo.t3 = __builtin_amdgcn_readfirstlane(META[3]); S.mo.t4 = __builtin_amdgcn_readfirstlane(META[4]); S.mo.t5 = __builtin_amdgcn_readfirstlane(META[5]); S.mo.t6 = __builtin_amdgcn_readfirstlane(META[6]); S.mo.t7 = __builtin_amdgcn_readfirstlane(META[7]); S.mo.estride = (size_t)DM * FFE;
        pg8::EpiScaleBf16Tail<DM> E{(bf16*)(ws + WS_YS), 1.0f / (F8_HSCALE * F8_WSCALE), (float*)(ws + WS_SLAB)}; pg8::gemm_phase<pg8::EpiScaleBf16Tail<DM>, pg8::MoeTailOrder<FFE / 128, FFE / 4>, true, true, true>(ring, g, S, E, F.wave);
    } SEAM(17);
    if (IN(18)) { moe_tail_reduce(args.ws); } SEAM(18);
    if (IN(19)) { combine_phase(F, args.in[16], args.out); }
#ifdef PROBE_T
    GRID_BAR();
    if (PROBE_T_END == NPHASE) PT_STAMP(1);
    GRID_BAR();
    { const unsigned tA = __hip_atomic_load((const unsigned*)((gu32*)(F.ws + WS_CTL) + 8), __ATOMIC_RELAXED, __HIP_MEMORY_SCOPE_AGENT), tB = __hip_atomic_load((const unsigned*)((gu32*)(F.ws + WS_CTL) + 9), __ATOMIC_RELAXED, __HIP_MEMORY_SCOPE_AGENT);
      const float code = (float)((tB - tA + PROBE_T_OFF * 100u) / (100u * PROBE_T_Q));
      for (unsigned i = blockIdx.x * 512u + threadIdx.x; i < (unsigned)MTOK * DM; i += gridDim.x * 512u) args.out[i] = code; }
#endif
#undef IN
#undef SEAM
#undef GRID_BAR
}

extern "C" void kernel_launch(void* const* d_in, const int* in_sizes, int n_in, void* d_out, int out_size, void* d_ws, size_t ws_size, hipStream_t stream) {
    static int grid = 0;
    if (grid == 0) {
        if (n_in != 17 || in_sizes[0] != MTOK * DM || out_size != MTOK * DM || ws_size < WS_END) { fprintf(stderr, "kernel_launch: unexpected shapes (n_in %d, in0 %d, out %d, ws %zu < %zu); nothing launched\n", n_in, n_in > 0 ? in_sizes[0] : -1, out_size, ws_size, (size_t)WS_END); grid = -1; return; }
        int dev = 0, cus = 0, per_cu = 0;
        if (hipGetDevice(&dev) != hipSuccess || hipDeviceGetAttribute(&cus, hipDeviceAttributeMultiprocessorCount, dev) != hipSuccess) { fprintf(stderr, "kernel_launch: device query failed\n"); grid = -1; return; }
        if (hipFuncSetAttribute((const void*)yoco_fwd, hipFuncAttributeMaxDynamicSharedMemorySize, LDS_BYTES) != hipSuccess) { fprintf(stderr, "kernel_launch: hipFuncSetAttribute failed\n"); grid = -1; return; }
        if (hipOccupancyMaxActiveBlocksPerMultiprocessor(&per_cu, (const void*)yoco_fwd, NWAVES * 64, LDS_BYTES) != hipSuccess || per_cu < 1) fprintf(stderr, "kernel_launch: note: occupancy query reports %d workgroups per CU\n", per_cu);
        (void)hipGetLastError();
        grid = cus;
        if (grid != 256) fprintf(stderr, "kernel_launch: %d CUs; this kernel is laid out for 256\n", grid);
    }
    if (grid < 0) return;
    if (hipMemsetAsync((char*)d_ws + WS_CTL, 0, CTL_ZERO_BYTES, stream) != hipSuccess) { fprintf(stderr, "kernel_launch: memset failed\n"); return; }
    Args a{};
    for (int i = 0; i < 17; ++i) a.in[i] = (const float*)d_in[i];
    a.out = (float*)d_out; a.ws = (unsigned char*)d_ws;
    for (int li = 0; li < N_LAUNCHES; ++li) {
#if defined(DBG) && DBG
        if (li == 6 || li == 9 || li == 13) { a.ph_lo = 1000 + (li - 2) + 49; a.ph_hi = a.ph_lo + 1; hipLaunchKernelGGL(yoco_fwd, dim3(grid), dim3(NWAVES * 64), LDS_BYTES, stream, a); }
#endif
        a.ph_lo = (N_LAUNCHES == 1) ? 0 : li; a.ph_hi = (N_LAUNCHES == 1) ? NPHASE : li + 1;
        hipLaunchKernelGGL(yoco_fwd, dim3(grid), dim3(NWAVES * 64), LDS_BYTES, stream, a);
#if defined(DBG) && DBG
        { const int phd = (li < 3) ? li : (li == 5) ? 3 : (li >= 6) ? li - 2 : 900; a.ph_lo = 1000 + phd; a.ph_hi = a.ph_lo + 1; hipLaunchKernelGGL(yoco_fwd, dim3(grid), dim3(NWAVES * 64), LDS_BYTES, stream, a);
          if (li == NPHASE - 1) { a.ph_lo = 1099; a.ph_hi = 1100; hipLaunchKernelGGL(yoco_fwd, dim3(grid), dim3(NWAVES * 64), LDS_BYTES, stream, a); } }
#endif
        const hipError_t le = hipPeekAtLastError();
        if (le != hipSuccess) { fprintf(stderr, "kernel_launch: launch %d failed: %s\n", li, hipGetErrorName(le)); break; }
    }
}
```
